# Optimizing an MI355X kernel written in HIP

```python
import math
import jax, jax.numpy as jnp
from jax import lax
import numpy as np

D_MODEL = 2048
BATCH = 16
SEQ = 256
DEPTH = 1
DEC_BATCH = 2
DEC_SEQ = 2048
PAST_LEN = 512

GRID_W = 64
CHUNK = 128
N_DIR = 2
MIX_M = D_MODEL // 2
M_HEADS = 4
M_DV = MIX_M // M_HEADS
M_DQK = M_DV // 2
MIX_S = D_MODEL - MIX_M
S_HEADDIM = 64
S_HEADS = MIX_S // S_HEADDIM
S_STATE = 128
S_GROUPS = 4
CONV_K = 3
D_FF = 4 * D_MODEL
EPS = 1e-6
IN_SIZES = (M_HEADS * M_DQK, M_HEADS * M_DQK, MIX_M, MIX_M, N_DIR * M_HEADS, N_DIR * M_HEADS,
            MIX_S, MIX_S + 2 * S_GROUPS * S_STATE, N_DIR * S_HEADS)
D_IN_PROJ = sum(IN_SIZES)

kernel_name = "bidir_mlstm_ssd_hybrid_diffusion_step"


def _split_points(sizes):
    pts, acc = [], 0
    for s in sizes[:-1]:
        acc += s
        pts.append(acc)
    return pts


def rmsnorm(x, g):
    xf = x.astype(jnp.float32)
    y = xf * lax.rsqrt(jnp.mean(xf * xf, -1, keepdims=True) + EPS)
    return (y * g.astype(jnp.float32)).astype(x.dtype)


def modulation(cond, w_mod, b_mod):
    m = jax.nn.silu(cond) @ w_mod + b_mod
    return jnp.split(m[:, None, :], 6, axis=-1)


def grid_dwconv(u, w, b, rows):
    bn, L, cn = u.shape
    img = u.reshape(bn, rows, L // rows, cn)
    out = lax.conv_general_dilated(img, w[:, :, None, :].astype(u.dtype), (1, 1), 'SAME',
                                   dimension_numbers=('NHWC', 'HWIO', 'NHWC'), feature_group_count=cn)
    return out.reshape(bn, L, cn) + b


def mlstm_chunkwise(q, k, v, i_pre, logf, c0, n0, m0):
    f32 = jnp.float32
    bn, H, L, dqk = q.shape
    nc = L // CHUNK

    def to_chunks(t):
        return jnp.moveaxis(t.astype(f32).reshape(bn, H, nc, CHUNK, *t.shape[3:]), 2, 0)

    qc, kc, vc, ic, fc = map(to_chunks, (q * (dqk ** -0.5), k, v, i_pre, logf))
    causal = jnp.tril(jnp.ones((CHUNK, CHUNK), bool))

    def step(carry, inp):
        C, n, m = carry
        qb, kb, vb, ib, fb = inp
        b = jnp.cumsum(fb, -1)
        dmat = jnp.where(causal, b[..., :, None] - b[..., None, :] + ib[..., None, :], -jnp.inf)
        m_inter = b + m[..., None]
        m_t = jnp.maximum(m_inter, jnp.max(dmat, -1))
        w_inter = jnp.exp(m_inter - m_t)
        s = jnp.einsum('bhtd,bhsd->bhts', qb, kb) * jnp.exp(dmat - m_t[..., None])
        num = w_inter[..., None] * jnp.einsum('bhtd,bhde->bhte', qb, C) + jnp.einsum('bhts,bhse->bhte', s, vb)
        den = w_inter * jnp.einsum('bhtd,bhd->bht', qb, n) + jnp.sum(s, -1)
        h = num / jnp.maximum(jnp.abs(den), jnp.exp(-m_t))[..., None]
        b_last = b[..., -1]
        g = b_last[..., None] - b + ib
        m_new = jnp.maximum(b_last + m, jnp.max(g, -1))
        decay = jnp.exp(b_last + m - m_new)
        wk = jnp.exp(g - m_new[..., None])
        C_new = decay[..., None, None] * C + jnp.einsum('bhs,bhsd,bhse->bhde', wk, kb, vb)
        n_new = decay[..., None] * n + jnp.einsum('bhs,bhsd->bhd', wk, kb)
        return (C_new, n_new, m_new), h

    (C, n, m), hs = lax.scan(step, (c0.astype(f32), n0.astype(f32), m0.astype(f32)), (qc, kc, vc, ic, fc))
    h = jnp.moveaxis(hs, 0, 2).reshape(bn, H, L, -1)
    return h, C, n, m


def ssd_chunkwise(x, dt, a, Bm, Cm, s0):
    f32 = jnp.float32
    bn, L, H, P = x.shape
    rep = H // S_GROUPS
    nc = L // CHUNK

    def to_chunks(t):
        return jnp.moveaxis(t.astype(f32).reshape(bn, nc, CHUNK, *t.shape[2:]), 1, 0)

    xg = to_chunks(x.reshape(bn, L, S_GROUPS, rep, P))
    dtg = dt.astype(f32).reshape(bn, L, S_GROUPS, rep)
    lag = to_chunks(dtg * a.astype(f32).reshape(S_GROUPS, rep))
    dtc = to_chunks(dtg)
    Bc, Cc = to_chunks(Bm), to_chunks(Cm)
    causal = jnp.tril(jnp.ones((CHUNK, CHUNK), bool))[None, :, :, None, None]

    def step(S, inp):
        xb, lab, dtb, Bb, Cb = inp
        cs = jnp.cumsum(lab, axis=1)
        seg = jnp.exp(jnp.where(causal, cs[:, :, None] - cs[:, None, :], -jnp.inf))
        cb = jnp.einsum('btgn,bsgn->btsg', Cb, Bb)
        mix = cb[..., None] * seg * dtb[:, None]
        y = jnp.einsum('btsgr,bsgrp->btgrp', mix, xb) + jnp.einsum('btgn,bgrpn,btgr->btgrp', Cb, S, jnp.exp(cs))
        tot = cs[:, -1]
        wk = jnp.exp(tot[:, None] - cs) * dtb
        S_new = jnp.exp(tot)[..., None, None] * S + jnp.einsum('bsgr,bsgrp,bsgn->bgrpn', wk, xb, Bb)
        return S_new, y

    S, ys = lax.scan(step, s0.astype(f32).reshape(bn, S_GROUPS, rep, P, S_STATE), (xg, lag, dtc, Bc, Cc))
    y = jnp.moveaxis(ys, 0, 1).reshape(bn, L, H, P)
    return y, S.reshape(bn, H, P, S_STATE)


def mixer(u, rows, state, p):
    f32 = jnp.float32
    bn, L, _ = u.shape
    c0, n0, m0, s0 = state
    q, k, v, o, ig, fg, z, xbc, dt = jnp.split(u @ p['w_in'], _split_points(IN_SIZES), axis=-1)

    def heads(t, d):
        return t.reshape(bn, L, M_HEADS, d).transpose(0, 2, 1, 3)
    qh, kh, vh = heads(q, M_DQK), heads(k, M_DQK), heads(v, M_DV)
    ig = (ig.astype(f32).reshape(bn, L, N_DIR, M_HEADS) + p['b_igate']).transpose(2, 0, 3, 1)
    lf = jax.nn.log_sigmoid(fg.astype(f32).reshape(bn, L, N_DIR, M_HEADS) + p['b_fgate']).transpose(2, 0, 3, 1)
    fl = lambda t: jnp.flip(t, axis=2)
    h_f, cf, nf, mf = mlstm_chunkwise(qh, kh, vh, ig[0], lf[0], c0[:, 0], n0[:, 0], m0[:, 0])
    h_b, cbk, nbk, mbk = mlstm_chunkwise(fl(qh), fl(kh), fl(vh), fl(ig[1]), fl(lf[1]), c0[:, 1], n0[:, 1], m0[:, 1])
    h_m = (h_f + fl(h_b)).transpose(0, 2, 1, 3).astype(u.dtype)
    h_m = rmsnorm(h_m, p['g_mlstm_norm'].reshape(M_HEADS, M_DV)).reshape(bn, L, MIX_M) * jax.nn.sigmoid(o)

    xbc = jax.nn.silu(grid_dwconv(xbc, p['conv_w'], p['conv_b'], rows))
    xs, Bs, Cs = jnp.split(xbc, [MIX_S, MIX_S + S_GROUPS * S_STATE], axis=-1)
    xs = xs.reshape(bn, L, S_HEADS, S_HEADDIM)
    Bs = Bs.reshape(bn, L, S_GROUPS, S_STATE)
    Cs = Cs.reshape(bn, L, S_GROUPS, S_STATE)
    dt = jax.nn.softplus(dt.astype(f32).reshape(bn, L, N_DIR, S_HEADS) + p['dt_bias'])
    a = -jnp.exp(p['a_log'].astype(f32))
    f1 = lambda t: jnp.flip(t, axis=1)
    y_f, sf = ssd_chunkwise(xs, dt[:, :, 0], a[0], Bs, Cs, s0[:, 0])
    y_b, sbk = ssd_chunkwise(f1(xs), f1(dt[:, :, 1]), a[1], f1(Bs), f1(Cs), s0[:, 1])
    y_s = (y_f + f1(y_b) + p['d_skip'][:, None].astype(f32) * xs.astype(f32)).astype(u.dtype)
    y_s = rmsnorm(y_s.reshape(bn, L, MIX_S) * jax.nn.silu(z), p['g_ssd_norm'])

    out = jnp.concatenate([h_m, y_s], axis=-1) @ p['w_out']
    new_state = (jnp.stack([cf, cbk], 1), jnp.stack([nf, nbk], 1), jnp.stack([mf, mbk], 1), jnp.stack([sf, sbk], 1))
    return out, new_state


def block(x, cond, rows, state, p):
    sh1, sc1, g1, sh2, sc2, g2 = modulation(cond, p['w_mod'], p['b_mod'])
    u = rmsnorm(x, p['g_pre_mix']) * (1.0 + sc1) + sh1
    mix, new_state = mixer(u, rows, state, p)
    x = x + g1 * rmsnorm(mix, p['g_post_mix'])
    u = rmsnorm(x, p['g_pre_mlp']) * (1.0 + sc2) + sh2
    hdn = jnp.square(jax.nn.relu(u @ p['w_mlp_in']))
    x = x + g2 * rmsnorm(hdn @ p['w_mlp_out'], p['g_post_mlp'])
    return x, new_state


def setup_inputs(seed: int = 0) -> dict:
    key = jax.random.key(seed)
    ks = iter(jax.random.split(key, 40))
    f32 = jnp.float32
    D = D_MODEL

    def nrm(shape, s):
        return s * jax.random.normal(next(ks), shape, f32)

    def gain(shape):
        return 1.0 + nrm(shape, 0.02)

    dt0 = jnp.exp(jax.random.uniform(next(ks), (DEPTH, N_DIR, S_HEADS), f32, math.log(1e-3), math.log(1e-1)))
    dt_bias = dt0 + jnp.log(-jnp.expm1(-dt0))
    a_log = jnp.log(jax.random.uniform(next(ks), (DEPTH, N_DIR, S_HEADS), f32, 1.0, 16.0))
    b_fgate = jax.random.uniform(next(ks), (DEPTH, N_DIR, M_HEADS), f32, 3.0, 6.0)
    return {
        "x_prompt": nrm((BATCH, SEQ, D), 1.0),
        "x_sample": nrm((DEC_BATCH, DEC_SEQ, D), 1.0),
        "state_mlstm_c": nrm((DEC_BATCH, DEPTH, N_DIR, M_HEADS, M_DQK, M_DV), 0.1),
        "state_mlstm_n": nrm((DEC_BATCH, DEPTH, N_DIR, M_HEADS, M_DQK), 0.5),
        "state_mlstm_m": nrm((DEC_BATCH, DEPTH, N_DIR, M_HEADS), 1.0),
        "state_ssd": nrm((DEC_BATCH, DEPTH, N_DIR, S_HEADS, S_HEADDIM, S_STATE), 0.1),
        "c": nrm((DEC_BATCH, D), 1.0),
        "c_ctx": nrm((D,), 1.0),
        "w_mod": nrm((DEPTH, D, 6 * D), 0.2 * D ** -0.5),
        "b_mod": nrm((DEPTH, 6 * D), 0.01),
        "g_pre_mix": gain((DEPTH, D)),
        "g_post_mix": gain((DEPTH, D)),
        "w_in": nrm((DEPTH, D, D_IN_PROJ), D ** -0.5),
        "b_igate": nrm((DEPTH, N_DIR, M_HEADS), 0.1),
        "b_fgate": b_fgate,
        "conv_w": nrm((DEPTH, CONV_K, CONV_K, MIX_S + 2 * S_GROUPS * S_STATE), (CONV_K * CONV_K) ** -0.5),
        "conv_b": nrm((DEPTH, MIX_S + 2 * S_GROUPS * S_STATE), 0.01),
        "dt_bias": dt_bias,
        "a_log": a_log,
        "d_skip": gain((DEPTH, S_HEADS)),
        "g_mlstm_norm": gain((DEPTH, MIX_M)),
        "g_ssd_norm": gain((DEPTH, MIX_S)),
        "w_out": nrm((DEPTH, D, D), D ** -0.5),
        "g_pre_mlp": gain((DEPTH, D)),
        "g_post_mlp": gain((DEPTH, D)),
        "w_mlp_in": nrm((DEPTH, D, D_FF), D ** -0.5),
        "w_mlp_out": nrm((DEPTH, D_FF, D), D_FF ** -0.5),
    }


def reference(x_prompt, x_sample, state_mlstm_c, state_mlstm_n, state_mlstm_m, state_ssd, c, c_ctx,
              w_mod, b_mod, g_pre_mix, g_post_mix, w_in, b_igate, b_fgate, conv_w, conv_b, dt_bias, a_log,
              d_skip, g_mlstm_norm, g_ssd_norm, w_out, g_pre_mlp, g_post_mlp, w_mlp_in, w_mlp_out):
    f32 = jnp.float32
    bp = x_prompt.shape[0]
    rows = x_sample.shape[1] // GRID_W
    zero_state = (jnp.zeros((bp, N_DIR, M_HEADS, M_DQK, M_DV), f32),
                  jnp.zeros((bp, N_DIR, M_HEADS, M_DQK), f32),
                  jnp.zeros((bp, N_DIR, M_HEADS), f32),
                  jnp.zeros((bp, N_DIR, S_HEADS, S_HEADDIM, S_STATE), f32))
    hp, hs = x_prompt, x_sample
    nc_list, nn_list, nm_list, ns_list = [], [], [], []
    for l in range(DEPTH):
        p = dict(w_mod=w_mod[l], b_mod=b_mod[l], g_pre_mix=g_pre_mix[l], g_post_mix=g_post_mix[l],
                 w_in=w_in[l], b_igate=b_igate[l], b_fgate=b_fgate[l], conv_w=conv_w[l], conv_b=conv_b[l],
                 dt_bias=dt_bias[l], a_log=a_log[l], d_skip=d_skip[l], g_mlstm_norm=g_mlstm_norm[l],
                 g_ssd_norm=g_ssd_norm[l], w_out=w_out[l], g_pre_mlp=g_pre_mlp[l], g_post_mlp=g_post_mlp[l],
                 w_mlp_in=w_mlp_in[l], w_mlp_out=w_mlp_out[l])
        hp, st = block(hp, c_ctx[None, :], 1, zero_state, p)
        nc_list.append(st[0]); nn_list.append(st[1]); nm_list.append(st[2]); ns_list.append(st[3])
        cache_l = (state_mlstm_c[:, l], state_mlstm_n[:, l], state_mlstm_m[:, l], state_ssd[:, l])
        hs, _ = block(hs, c, rows, cache_l, p)
    new_c = jnp.stack(nc_list, 1).astype(x_prompt.dtype)
    new_n = jnp.stack(nn_list, 1).astype(x_prompt.dtype)
    new_m = jnp.stack(nm_list, 1).astype(x_prompt.dtype)
    new_s = jnp.stack(ns_list, 1).astype(x_prompt.dtype)
    return (hp, hs, new_c, new_n, new_m, new_s)
```

```cpp
#include <hip/hip_runtime.h>
#include <hip/hip_cooperative_groups.h>
#include <cstdio>
#include <cstdint>
namespace cg = cooperative_groups;
namespace pg8 {
#define PG8_LAS __attribute__((address_space(3)))
typedef unsigned short bf16_t;
typedef short bf16x8 __attribute__((ext_vector_type(8)));
typedef float f32x4 __attribute__((ext_vector_type(4)));
typedef unsigned u32x4 __attribute__((ext_vector_type(4)));
typedef int i32x8 __attribute__((ext_vector_type(8)));
constexpr int BM = 256, BK = 64, HALF = 128, HTB = HALF * BK * 2  , STAGE_BYTES = 8 * HTB, NXCD = 1, WGM = 4;

__host__ __device__ __forceinline__ int lds_byte(int r, int c) { const int st = (r >> 4) * 2 + (c >> 5), rr = r & 15, cc = c & 31, ob = rr * 64 + cc * 2; return st * 1024 + (ob ^ (((ob >> 9) & 1) << 5)); }
__host__ __device__ __forceinline__ void stage_rc(int b, int& R, int& C) { const int st = b / 1024, sb = b % 1024, swz = sb ^ (((sb >> 9) & 1) << 5); R = (st >> 1) * 16 + swz / 64; C = (st & 1) * 32 + (swz % 64) / 2; }
__host__ __device__ __forceinline__ int perm32(int rho) { const int n = rho >> 4, i = rho & 15; return 8 * (i >> 2) + 4 * n + (i & 3); }

struct Unit { int pm, pn; };
struct Gemm { const bf16_t* A; const bf16_t* Bt; int M, N, K; };

struct StaticOrder {
    int nM, nN, nwg, G, c;
    __host__ __device__ void init(int M, int N, int G_, int c_) { nM = M / BM; nN = N / BM; nwg = nM * nN; G = G_; c = c_; }
    __host__ __device__ bool next(int i, Unit& u) const {
        const long L = (long)i * G + c; if (L >= nwg) return false;
        int wgid = (int)L; { const int q = nwg / NXCD, r = nwg % NXCD, xcd = wgid % NXCD, off = wgid / NXCD; wgid = (xcd < r ? xcd * (q + 1) : r * (q + 1) + (xcd - r) * q) + off; }
        const int nig = WGM * nN, gid = wgid / nig, fm = gid * WGM, gsz = (nM - fm) < WGM ? (nM - fm) : WGM;
        u.pm = fm + ((wgid % nig) % gsz); u.pn = (wgid % nig) / gsz; return true;
    }
    __device__ __forceinline__ void a_ready(const Unit&) const {}
    __device__ __forceinline__ void done(const Unit&) const {}
};
struct SkipOrder {
    StaticOrder base; int skip_from, skip_by;
    __host__ __device__ bool next(int i, Unit& u) const { if (!base.next(i, u)) return false; if (u.pn >= skip_from) u.pn += skip_by; return true; }
    __device__ __forceinline__ void a_ready(const Unit&) const {}
    __device__ __forceinline__ void done(const Unit&) const {}
};
__device__ __forceinline__ unsigned cvt_pk_bf16(float lo, float hi) { unsigned r; asm volatile("v_cvt_pk_bf16_f32 %0, %1, %2" : "=v"(r) : "v"(lo), "v"(hi)); return r; }
template <int ACT> struct EpiBf16 {
    static constexpr bool PERM = true, AFTER_DRAIN = false;
    bf16_t* O; int ldc;
    __device__ __forceinline__ void operator()(const f32x4 (&acc)[2][2][4][2], const Unit& u, int wr, int wc, int fr, int fq, bool last) const {
        const int row0 = u.pm * BM + wr * 64 + fr; const int col0 = u.pn * BM + wc * 32 + 8 * fq;
#pragma unroll
        for (int ai = 0; ai < 2; ++ai)
#pragma unroll
            for (int m = 0; m < 4; ++m) { bf16_t* rowp = O + (size_t)(row0 + ai * HALF + m * 16) * ldc + col0;
#pragma unroll
                for (int bj = 0; bj < 2; ++bj) { f32x4 v0 = acc[ai][bj][m][0], v1 = acc[ai][bj][m][1];
                    if (ACT == 1) {
#pragma unroll
                        for (int j = 0; j < 4; ++j) { const float a = fmaxf(v0[j], 0.f), b = fmaxf(v1[j], 0.f); v0[j] = a * a; v1[j] = b * b; } }
                    u32x4 w; w.x = cvt_pk_bf16(v0[0], v0[1]); w.y = cvt_pk_bf16(v0[2], v0[3]); w.z = cvt_pk_bf16(v1[0], v1[1]); w.w = cvt_pk_bf16(v1[2], v1[3]);
                    if (last) asm volatile("global_store_dwordx4 %0, %1, off sc1\n\ts_nop 1" :: "v"(rowp + bj * HALF), "v"(w) : "memory"); else *(u32x4*)(rowp + bj * HALF) = w; } }
    }
};
struct EpiFp8Relu2 {
    static constexpr bool PERM = true, AFTER_DRAIN = false;
    unsigned char* O; int ldc;
    __device__ __forceinline__ void operator()(const f32x4 (&acc)[2][2][4][2], const Unit& u, int wr, int wc, int fr, int fq, bool last) const {
        typedef unsigned u32x2 __attribute__((ext_vector_type(2)));
        const int row0 = u.pm * BM + wr * 64 + fr; const int col0 = u.pn * BM + wc * 32 + 8 * fq;
#pragma unroll
        for (int ai = 0; ai < 2; ++ai)
#pragma unroll
            for (int m = 0; m < 4; ++m) { unsigned char* rowp = O + (size_t)(row0 + ai * HALF + m * 16) * ldc + col0;
#pragma unroll
                for (int bj = 0; bj < 2; ++bj) { f32x4 v0 = acc[ai][bj][m][0], v1 = acc[ai][bj][m][1];
#pragma unroll
                    for (int j = 0; j < 4; ++j) { const float a = fmaxf(v0[j], 0.f), b = fmaxf(v1[j], 0.f); v0[j] = a * a; v1[j] = b * b; }
                    int p0 = __builtin_amdgcn_cvt_pk_fp8_f32(v0[0], v0[1], 0, false); p0 = __builtin_amdgcn_cvt_pk_fp8_f32(v0[2], v0[3], p0, true);
                    int p1 = __builtin_amdgcn_cvt_pk_fp8_f32(v1[0], v1[1], 0, false); p1 = __builtin_amdgcn_cvt_pk_fp8_f32(v1[2], v1[3], p1, true);
                    const u32x2 w = {(unsigned)p0, (unsigned)p1};
                    if (last) asm volatile("global_store_dwordx2 %0, %1, off sc1\n\ts_nop 1" :: "v"(rowp + bj * HALF), "v"(w) : "memory"); else *(u32x2*)(rowp + bj * HALF) = w; } }
    }
};
struct EpiF32 {
    static constexpr bool PERM = false, AFTER_DRAIN = false;
    float* O; int ldc;
    __device__ __forceinline__ void operator()(const f32x4 (&acc)[2][2][4][2], const Unit& u, int wr, int wc, int fr, int fq, bool) const {
        const int row0 = u.pm * BM + wr * 64 + fr; const int col0 = u.pn * BM + wc * 32 + 4 * fq;
#pragma unroll
        for (int ai = 0; ai < 2; ++ai)
#pragma unroll
            for (int m = 0; m < 4; ++m) { float* rowp = O + (size_t)(row0 + ai * HALF + m * 16) * ldc + col0;
#pragma unroll
                for (int bj = 0; bj < 2; ++bj)
#pragma unroll
                    for (int n = 0; n < 2; ++n) *(f32x4*)(rowp + bj * HALF + n * 16) = acc[ai][bj][m][n]; }
    }
};
template <bool F8> struct FragSel { typedef bf16x8 T; static constexpr int KF = 2; };
template <> struct FragSel<true> { typedef i32x8 T; static constexpr int KF = 1; };
template <class Epi, class Sched, bool ALIGN_EPI = false, bool SP2 = false, bool F8 = false>
__device__ __forceinline__ void gemm_phase(PG8_LAS unsigned char* lds, const Gemm g, const Sched& S, const Epi& E) {
    int tid_o = threadIdx.x; asm volatile("" : "+v"(tid_o));
    const int tid = tid_o, wid = __builtin_amdgcn_readfirstlane(tid >> 6), lane = tid & 63, wr = wid >> 2, wc = wid & 3, fr = lane & 15, fq = lane >> 4;
    const int K = g.K, nt = K / BK;
    unsigned voffA[2], voffB[2];
#pragma unroll
    for (int i = 0; i < 2; ++i) { int R, C; stage_rc(tid * 16 + i * 8192, R, C); const int Rb = Epi::PERM ? ((R & ~31) + perm32(R & 31)) : R;
        voffA[i] = (unsigned)(R * K + C) * 2u; voffB[i] = (unsigned)(Rb * K + C) * 2u; }
    const size_t kstep = (size_t)(BK * 2);
    const size_t hstep = (size_t)HALF * K * 2;
    const size_t tstep = 2 * hstep;
    const unsigned ldsw = (unsigned)wid * 1024u;
    const int aoff = lds_byte(wr * 64 + fr, fq * 8), boff = lds_byte(wc * 32 + fr, fq * 8);
#define PG8_SA(b, h) (((b) * 2 + (h)) * HTB)
#define PG8_SB(b, h) ((4 + (b) * 2 + (h)) * HTB)
#define PG8_STAGE(bufoff, gbase, voff) do { _Pragma("unroll") for (int _i = 0; _i < 2; ++_i) \
        __builtin_amdgcn_global_load_lds((const unsigned*)((const char*)(gbase) + (voff)[_i]), (PG8_LAS unsigned*)(lds + (bufoff) + ldsw + _i * 8192), 16, 0, 0); } while (0)
#define PG8_CAT(x, y) __builtin_bit_cast(i32x8, __builtin_shufflevector(x, y, 0, 1, 2, 3, 4, 5, 6, 7, 8, 9, 10, 11, 12, 13, 14, 15))
#define PG8_LDA(dst, b, h) do { _Pragma("unroll") for (int m = 0; m < 4; ++m) { if constexpr (F8) dst[m][0] = PG8_CAT(*(const PG8_LAS bf16x8*)(lds + PG8_SA(b, h) + aoff + m * 2048), *(const PG8_LAS bf16x8*)(lds + PG8_SA(b, h) + aoff + m * 2048 + 1024)); \
        else { _Pragma("unroll") for (int k = 0; k < KF; ++k) dst[m][k] = *(const PG8_LAS frag_t*)(lds + PG8_SA(b, h) + aoff + m * 2048 + k * 1024); } } } while (0)
#define PG8_LDB(dst, b, h) do { _Pragma("unroll") for (int n = 0; n < 2; ++n) { if constexpr (F8) dst[n][0] = PG8_CAT(*(const PG8_LAS bf16x8*)(lds + PG8_SB(b, h) + boff + n * 2048), *(const PG8_LAS bf16x8*)(lds + PG8_SB(b, h) + boff + n * 2048 + 1024)); \
        else { _Pragma("unroll") for (int k = 0; k < KF; ++k) dst[n][k] = *(const PG8_LAS frag_t*)(lds + PG8_SB(b, h) + boff + n * 2048 + k * 1024); } } } while (0)
#define PG8_MMA(ai, bj, At, Bt) do { __builtin_amdgcn_s_setprio(1); _Pragma("unroll") for (int m = 0; m < 4; ++m) _Pragma("unroll") for (int n = 0; n < 2; ++n) { \
        if constexpr (F8) asm volatile("v_mfma_scale_f32_16x16x128_f8f6f4 %0, %1, %2, %0, %3, %4 op_sel_hi:[0,0,0]" : "+v"(acc[ai][bj][m][n]) : "v"(Bt[n][0]), "v"(At[m][0]), "v"(sc_w), "v"(sc_a)); \
        else { _Pragma("unroll") for (int k = 0; k < KF; ++k) acc[ai][bj][m][n] = __builtin_amdgcn_mfma_f32_16x16x32_bf16(Bt[n][k], At[m][k], acc[ai][bj][m][n], 0, 0, 0); } } \
        if constexpr (F8) asm volatile("s_nop 7\n\ts_nop 7" ::: "memory");     \
        __builtin_amdgcn_s_setprio(0); } while (0)
#define PG8_WAIT_V(n) asm volatile("s_waitcnt vmcnt(" #n ")" ::: "memory")
#define PG8_WAIT_L(n) asm volatile("s_waitcnt lgkmcnt(" #n ")" ::: "memory")
#define PG8_BAR __builtin_amdgcn_s_barrier()
#define PG8_SCHED __builtin_amdgcn_sched_barrier(0)
    Unit cur, nxt; int ui = 0;
    if (!S.next(0, cur)) return;
    f32x4 acc[2][2][4][2];
#pragma unroll
    for (int a = 0; a < 2; ++a)
#pragma unroll
        for (int b = 0; b < 2; ++b)
#pragma unroll
            for (int m = 0; m < 4; ++m)
#pragma unroll
                for (int n = 0; n < 2; ++n) acc[a][b][m][n] = (f32x4){0.f, 0.f, 0.f, 0.f};
    typedef typename FragSel<F8>::T frag_t; constexpr int KF = FragSel<F8>::KF;
    frag_t At[4][KF], B0[2][KF], B1[2][KF];
    int sc_w = 0x78787878, sc_a = 0x7f7f7f7f; asm volatile("" : "+v"(sc_w), "+v"(sc_a));
    (void)sc_w; (void)sc_a;
    const char* cA = (const char*)g.A + (size_t)cur.pm * tstep; const char* cB = (const char*)g.Bt + (size_t)cur.pn * tstep;
    S.a_ready(cur);
    if constexpr (SP2) {
        PG8_STAGE(PG8_SB(0, 0), cB, voffB); PG8_STAGE(PG8_SB(0, 1), cB + hstep, voffB); PG8_STAGE(PG8_SA(0, 0), cA, voffA); PG8_STAGE(PG8_SA(0, 1), cA + hstep, voffA);
        if (wr == 1) PG8_BAR;
        PG8_WAIT_V(2); PG8_BAR;
        PG8_STAGE(PG8_SB(1, 0), cB + kstep, voffB); PG8_STAGE(PG8_SA(1, 0), cA + kstep, voffA); PG8_STAGE(PG8_SB(1, 1), cB + hstep + kstep, voffB);
        PG8_WAIT_V(6); PG8_BAR;
    } else {
        PG8_STAGE(PG8_SB(0, 0), cB, voffB); PG8_STAGE(PG8_SA(0, 0), cA, voffA); PG8_STAGE(PG8_SB(0, 1), cB + hstep, voffB); PG8_STAGE(PG8_SA(0, 1), cA + hstep, voffA);
        if (wr == 1) PG8_BAR;
        PG8_WAIT_V(4); PG8_BAR;
        PG8_STAGE(PG8_SB(1, 0), cB + kstep, voffB); PG8_STAGE(PG8_SA(1, 0), cA + kstep, voffA); PG8_STAGE(PG8_SB(1, 1), cB + hstep + kstep, voffB);
        PG8_WAIT_V(6); PG8_BAR;
    }
    for (;;) {
        const bool has_next = S.next(ui + 1, nxt);
        const char* nA = has_next ? (const char*)g.A + (size_t)nxt.pm * tstep : cA; const char* nB = has_next ? (const char*)g.Bt + (size_t)nxt.pn * tstep : cB;
        for (int t = 0; t < nt; t += 2) {
            const bool last = (t == nt - 2);
            const char* a1 = cA + (size_t)(t + 1) * kstep;
            const char* a2 = last ? nA : cA + (size_t)(t + 2) * kstep; const char* b2 = last ? nB : cB + (size_t)(t + 2) * kstep;
            const char* a3 = a2 + kstep; const char* b3 = b2 + kstep;
            if (last && has_next) S.a_ready(nxt);
            if constexpr (SP2) {
            PG8_LDB(B0, 0, 0); PG8_LDB(B1, 0, 1); PG8_SCHED; PG8_LDA(At, 0, 0); PG8_STAGE(PG8_SA(1, 1), a1 + hstep, voffA);
            PG8_WAIT_V(8); PG8_WAIT_L(0); PG8_BAR; PG8_MMA(0, 0, At, B0); PG8_MMA(0, 1, At, B1); PG8_BAR; PG8_SCHED;
            PG8_LDA(At, 0, 1); PG8_STAGE(PG8_SB(0, 0), b2, voffB); PG8_STAGE(PG8_SB(0, 1), b2 + hstep, voffB); PG8_STAGE(PG8_SA(0, 0), a2, voffA);
            PG8_WAIT_V(8); PG8_WAIT_L(0); PG8_BAR; PG8_MMA(1, 0, At, B0); PG8_MMA(1, 1, At, B1); PG8_BAR; PG8_SCHED;
            PG8_LDB(B0, 1, 0); PG8_LDB(B1, 1, 1); PG8_SCHED; PG8_LDA(At, 1, 0); PG8_STAGE(PG8_SA(0, 1), a2 + hstep, voffA);
            PG8_WAIT_V(8); PG8_WAIT_L(0); PG8_BAR; PG8_MMA(0, 0, At, B0); PG8_MMA(0, 1, At, B1); PG8_BAR; PG8_SCHED;
            PG8_LDA(At, 1, 1); PG8_STAGE(PG8_SB(1, 0), b3, voffB); PG8_STAGE(PG8_SB(1, 1), b3 + hstep, voffB); PG8_STAGE(PG8_SA(1, 0), a3, voffA);
            PG8_WAIT_V(8); PG8_WAIT_L(0); PG8_BAR; PG8_MMA(1, 0, At, B0); PG8_MMA(1, 1, At, B1); PG8_BAR; PG8_SCHED;
            } else {
            PG8_LDB(B0, 0, 0); PG8_SCHED; PG8_LDA(At, 0, 0); PG8_STAGE(PG8_SA(1, 1), a1 + hstep, voffA);
            PG8_WAIT_L(8); PG8_BAR; PG8_WAIT_L(0); PG8_MMA(0, 0, At, B0); PG8_BAR; PG8_SCHED;
            PG8_LDB(B1, 0, 1); PG8_STAGE(PG8_SB(0, 0), b2, voffB);
            PG8_BAR; PG8_WAIT_L(0); PG8_MMA(0, 1, At, B1); PG8_BAR;
            PG8_LDA(At, 0, 1); PG8_STAGE(PG8_SA(0, 0), a2, voffA);
            PG8_BAR; PG8_WAIT_L(0); PG8_MMA(1, 0, At, B0); PG8_BAR; PG8_SCHED;
            PG8_STAGE(PG8_SB(0, 1), b2 + hstep, voffB);
            PG8_WAIT_V(6); PG8_BAR; PG8_MMA(1, 1, At, B1); PG8_BAR;
            PG8_LDB(B0, 1, 0); PG8_SCHED; PG8_LDA(At, 1, 0); PG8_STAGE(PG8_SA(0, 1), a2 + hstep, voffA);
            PG8_WAIT_L(8); PG8_BAR; PG8_WAIT_L(0); PG8_MMA(0, 0, At, B0); PG8_BAR; PG8_SCHED;
            PG8_LDB(B1, 1, 1); PG8_STAGE(PG8_SB(1, 0), b3, voffB);
            PG8_BAR; PG8_WAIT_L(0); PG8_MMA(0, 1, At, B1); PG8_BAR;
            PG8_LDA(At, 1, 1); PG8_STAGE(PG8_SA(1, 0), a3, voffA);
            PG8_BAR; PG8_WAIT_L(0); PG8_MMA(1, 0, At, B0); PG8_BAR; PG8_SCHED;
            PG8_STAGE(PG8_SB(1, 1), b3 + hstep, voffB);
            PG8_WAIT_V(6); PG8_BAR; PG8_MMA(1, 1, At, B1); PG8_BAR;
            }
        }
        if constexpr (ALIGN_EPI) { if (wr == 0) PG8_BAR; }
        if constexpr (!Epi::AFTER_DRAIN) { E(acc, cur, wr, wc, fr, fq, !has_next); S.done(cur); }
        if (!has_next) break;
#pragma unroll
        for (int a = 0; a < 2; ++a)
#pragma unroll
            for (int b = 0; b < 2; ++b)
#pragma unroll
                for (int m = 0; m < 4; ++m)
#pragma unroll
                    for (int n = 0; n < 2; ++n) acc[a][b][m][n] = (f32x4){0.f, 0.f, 0.f, 0.f};
        cur = nxt; cA = nA; cB = nB; ++ui;
        if constexpr (ALIGN_EPI) { if (wr == 1) PG8_BAR; }
    }
    PG8_WAIT_V(0);
    if constexpr (!ALIGN_EPI) { if (wr == 0) PG8_BAR; }
    PG8_BAR;
    if constexpr (Epi::AFTER_DRAIN) { E.fused(acc, cur, wr, wc, fr, fq, lds, wid, lane); S.done(cur); }
#undef PG8_SA
#undef PG8_SB
#undef PG8_STAGE
#undef PG8_LDA
#undef PG8_LDB
#undef PG8_MMA
#undef PG8_WAIT_V
#undef PG8_WAIT_L
#undef PG8_BAR
#undef PG8_SCHED
}
}
#define LAS __attribute__((address_space(3)))
typedef LAS unsigned char lds8;
typedef unsigned short bf16_t;
typedef short bf16x8 __attribute__((ext_vector_type(8)));
typedef float f32x4 __attribute__((ext_vector_type(4)));
typedef unsigned u32x4 __attribute__((ext_vector_type(4)));
typedef unsigned u32x2 __attribute__((ext_vector_type(2)));
typedef float f32x2_t __attribute__((ext_vector_type(2)));
typedef __bf16 bf16x2_t __attribute__((ext_vector_type(2)));

constexpr int DM = 2048, NTOK = 8192, NPR = 4096, DFF = 8192, NPJ = 6144, NGATE = 48, WIN_N = 6192;
constexpr float EPS = 1e-6f;
constexpr int NTHR = 512;
constexpr int LDS_BYTES = 163840;
constexpr size_t MiB = 1u << 20;
constexpr size_t WS_MODC = 1 * MiB + 512 * 1024;
constexpr size_t WS_CTL = 0, WS_MOD = 1 * MiB, WS_G = 2 * MiB, WS_WG = 4 * MiB, WS_WIN = 5 * MiB, WS_WOUT = 29 * MiB, WS_WMI = 37 * MiB, WS_WMO = 69 * MiB,
                 WS_U = 101 * MiB, WS_P = 133 * MiB, WS_XC = 229 * MiB, WS_HDN = 133 * MiB, WS_HY = 261 * MiB, WS_MIX = 261 * MiB, WS_PRE = 325 * MiB, WS_X1 = 329 * MiB, WS_U8 = 361 * MiB, WS_WIN8 = 377 * MiB, WS_END = 381 * MiB;
constexpr size_t HY_STRIDE = (size_t)NTOK * 1024;
constexpr size_t PRE_SSD_OFF = (size_t)512 * 3 * 128;
constexpr size_t O_Y = 0, O_C = 16777216, O_N = O_C + 4194304, O_M = O_N + 16384, O_S = O_M + 128;

struct Args { const float* in[27]; float* out; unsigned char* ws; };
enum { I_XP = 0, I_XS, I_SC, I_SN, I_SM, I_SS, I_C, I_CCTX, I_WMOD, I_BMOD, I_GPREMIX, I_GPOSTMIX, I_WIN, I_BIG, I_BFG, I_CONVW, I_CONVB, I_DTB, I_ALOG, I_DSKIP,
       I_GML, I_GSSD, I_WOUT, I_GPREMLP, I_GPOSTMLP, I_WMI, I_WMO };

__device__ __forceinline__ unsigned pk2(float lo, float hi) { f32x2_t v = {lo, hi}; bf16x2_t b = __builtin_convertvector(v, bf16x2_t); return __builtin_bit_cast(unsigned, b); }
__device__ __forceinline__ float bflo(unsigned w) { return __uint_as_float(w << 16); }
__device__ __forceinline__ float bfhi(unsigned w) { return __uint_as_float(w & 0xffff0000u); }
__device__ __forceinline__ float wave_sum(float v) {
#pragma unroll
    for (int o = 1; o < 64; o <<= 1) v += __shfl_xor(v, o);
    return v;
}
#define LDS_WAIT() asm volatile("s_waitcnt lgkmcnt(0)" ::: "memory")
#define SBAR0() __builtin_amdgcn_sched_barrier(0)
__device__ __forceinline__ const float* xrow_ptr(const Args& a, int row) { return row < NPR ? a.in[I_XP] + (size_t)row * DM : a.in[I_XS] + (size_t)(row - NPR) * DM; }
__device__ __forceinline__ int cond_of(int row) { return row < NPR ? 0 : 1 + ((row - NPR) >> 11); }
__device__ __forceinline__ float siluf(float v) { return v / (1.f + __expf(-v)); }
__device__ __forceinline__ float sigmf(float v) { return 1.f / (1.f + __expf(-v)); }

#define XB_TMO      128
#define XB_XCNT(j)  (256  + 64 * (j))
#define XB_XSUB(j)  (1280 + 64 * (j))
#define XB_XGEN(j)  (2304 + 64 * (j))
#define XB_TOP      3328
#define XB_TOPGEN   3392
#define XCD_BAR_WORDS 3456
#define XB_SPIN_CAP (1u << 18)

__device__ __forceinline__ unsigned xb_ld(unsigned* p)              { return __hip_atomic_load(p, __ATOMIC_RELAXED, __HIP_MEMORY_SCOPE_AGENT); }
__device__ __forceinline__ unsigned xb_add(unsigned* p, unsigned v) { return __hip_atomic_fetch_add(p, v, __ATOMIC_RELAXED, __HIP_MEMORY_SCOPE_AGENT); }
__device__ __forceinline__ unsigned xb_xcc_id() { return (unsigned)__builtin_amdgcn_s_getreg((3 << 11) | 20) & 0xFu; }
#define XB_SPIN(cond, bar) do { unsigned _sp = 0; while (cond) { __builtin_amdgcn_s_sleep(1); \
    if ((++_sp & 255u) == 0u) { if (xb_ld(&(bar)[XB_TMO])) break; if (_sp > XB_SPIN_CAP) { atomicAdd(&(bar)[XB_TMO], 1u); break; } } } } while (0)

struct XcdBarrier {
    unsigned* bar; unsigned x;
    volatile LAS unsigned* st;
};

__device__ __forceinline__ XcdBarrier xcd_barrier_post(unsigned* bar, volatile LAS unsigned* st) {
    XcdBarrier b; b.bar = bar; b.x = xb_xcc_id(); b.st = st;
    if (threadIdx.x == 0) (void)xb_add(&bar[XB_XCNT(b.x)], 1u);
    return b;
}
__device__ __forceinline__ void xcd_barrier_complete(unsigned* bar, unsigned x, unsigned& nloc, unsigned& nx) {
    const unsigned G = gridDim.x * gridDim.y * gridDim.z;
    unsigned sum, cnt, mine, sp = 0u;
    for (;;) {
        sum = 0u; cnt = 0u; mine = 0u;
#pragma unroll
        for (unsigned j = 0; j < 16; ++j) { const unsigned c = xb_ld(&bar[XB_XCNT(j)]); sum += c; cnt += (c > 0u) ? 1u : 0u; mine = (j == x) ? c : mine; }
        if (sum == G) break;
        __builtin_amdgcn_s_sleep(1);
        if ((++sp & 255u) == 0u) { if (xb_ld(&bar[XB_TMO])) break; if (sp > XB_SPIN_CAP) { atomicAdd(&bar[XB_TMO], 1u); break; } }
    }
    nloc = mine > 0u ? mine : 1u; nx = cnt > 0u ? cnt : 1u;
}

__device__ __forceinline__ void xcd_barrier(const XcdBarrier& b) {
    asm volatile("s_waitcnt vmcnt(0)" ::: "memory");
    __syncthreads();
    if (threadIdx.x == 0) {
        unsigned* bar = b.bar;
        __builtin_amdgcn_s_waitcnt(0);
        unsigned nloc = b.st[0], nx = b.st[1];
        if (nloc == 0u) { xcd_barrier_complete(bar, b.x, nloc, nx); b.st[0] = nloc; b.st[1] = nx; }
        const unsigned old = xb_add(&bar[XB_XSUB(b.x)], 1u);
        const unsigned gen = old / nloc;
        if (old + 1u == (gen + 1u) * nloc) {
            __builtin_amdgcn_fence(__ATOMIC_RELEASE, "agent");
            asm volatile("s_waitcnt vmcnt(0)" ::: "memory");
            const unsigned og = xb_add(&bar[XB_TOP], 1u);
            const unsigned tg = og / nx;
            if (og + 1u == (tg + 1u) * nx) xb_add(&bar[XB_TOPGEN], 1u);
            else XB_SPIN(xb_ld(&bar[XB_TOPGEN]) == tg, bar);
            __builtin_amdgcn_fence(__ATOMIC_ACQUIRE, "agent");
            xb_add(&bar[XB_XGEN(b.x)], 1u);
            asm volatile("s_waitcnt vmcnt(0)" ::: "memory");
        } else {
            XB_SPIN(xb_ld(&bar[XB_XGEN(b.x)]) == gen, bar);
            __builtin_amdgcn_fence(__ATOMIC_ACQUIRE, "agent");
            asm volatile("s_waitcnt vmcnt(0)" ::: "memory");
        }
    }
    __syncthreads();
}

__device__ __forceinline__ void p0_transpose_item64(const float* __restrict__ W, int N, bf16_t* __restrict__ WT, int K, int k0, int n0src, int n0dst, LAS float* scr, int lane) {
    const int kr = lane >> 4, cq = lane & 15;
    f32x4 v[16];
#pragma unroll
    for (int i = 0; i < 16; ++i) v[i] = *(const f32x4*)(W + (size_t)(k0 + 4 * i + kr) * N + n0src + 4 * cq);
#pragma unroll
    for (int i = 0; i < 16; ++i) { LAS float* p = scr + (4 * i + kr) * 65 + 4 * cq; p[0] = v[i][0]; p[1] = v[i][1]; p[2] = v[i][2]; p[3] = v[i][3]; }
    LDS_WAIT();
    const int c = lane & 7, nn = lane >> 3;
#pragma unroll
    for (int jj = 0; jj < 8; ++jj) { const int n = nn + 8 * jj; const LAS float* s = scr + (8 * c) * 65 + n;
        u32x4 o; o.x = pk2(s[0], s[65]); o.y = pk2(s[2 * 65], s[3 * 65]); o.z = pk2(s[4 * 65], s[5 * 65]); o.w = pk2(s[6 * 65], s[7 * 65]);
        *(u32x4*)(WT + (size_t)(n0dst + n) * K + k0 + 8 * c) = o; }
    LDS_WAIT();
}

constexpr int TI_1 = 32 * 96, TI_2 = 32 * 32, TI_3 = 32 * 128, TI_4 = 128 * 32, TI_ALL = TI_1 + TI_2 + TI_3 + TI_4;
struct TItem { const float* W; bf16_t* WT; int N, K, k0, ns, nd, f8; };
__device__ __forceinline__ TItem titem_decode(const Args& a, int r) {
    TItem t;
    if (r < TI_1) { const int kb = r / 96, nb = r % 96, nd = 64 * nb; const bool oz = nd >= 2048 && nd < 4096;
        t.f8 = oz ? 1 : 0; t.W = a.in[I_WIN]; t.WT = oz ? (bf16_t*)(a.ws + WS_WIN8) : (bf16_t*)(a.ws + WS_WIN); t.N = WIN_N; t.K = DM; t.k0 = 64 * kb; t.ns = nd + (nd >= 3072 ? 16 : 0); t.nd = oz ? nd - 2048 : nd; return t; } r -= TI_1;
    if (r < TI_2) { const int kb = r / 32, nb = r % 32; t.f8 = 1; t.W = a.in[I_WOUT]; t.WT = (bf16_t*)(a.ws + WS_WOUT); t.N = DM; t.K = DM; t.k0 = 64 * kb; t.ns = 64 * nb; t.nd = 64 * nb; return t; } r -= TI_2;
    if (r < TI_3) { const int kb = r / 128, nb = r % 128; t.f8 = 1; t.W = a.in[I_WMI]; t.WT = (bf16_t*)(a.ws + WS_WMI); t.N = DFF; t.K = DM; t.k0 = 64 * kb; t.ns = 64 * nb; t.nd = 64 * nb; return t; } r -= TI_3;
    { const int kb = r / 32, nb = r % 32; t.f8 = 1; t.W = a.in[I_WMO]; t.WT = (bf16_t*)(a.ws + WS_WMO); t.N = DM; t.K = DFF; t.k0 = 64 * kb; t.ns = 64 * nb; t.nd = 64 * nb; return t; }
}
__device__ __forceinline__ void titem_load(const TItem& t, int lane, f32x4 (&v)[16]) {
    const int kr = lane >> 4, cq = lane & 15;
#pragma unroll
    for (int i = 0; i < 16; ++i) v[i] = *(const f32x4*)(t.W + (size_t)(t.k0 + 4 * i + kr) * t.N + t.ns + 4 * cq);
}
__device__ __forceinline__ void titem_store(const TItem& t, int lane, const f32x4 (&v)[16], LAS float* scr) {
    const int kr = lane >> 4, cq = lane & 15;
#pragma unroll
    for (int i = 0; i < 16; ++i) { LAS float* p = scr + (4 * i + kr) * 65 + 4 * cq; p[0] = v[i][0]; p[1] = v[i][1]; p[2] = v[i][2]; p[3] = v[i][3]; }
    LDS_WAIT();
    const int c = lane & 7, nn = lane >> 3;
#pragma unroll
    for (int jj = 0; jj < 8; ++jj) { const int n = nn + 8 * jj; const LAS float* q = scr + (8 * c) * 65 + n;
        if (t.f8) { int p0 = __builtin_amdgcn_cvt_pk_fp8_f32(128.f * q[0], 128.f * q[65], 0, false); p0 = __builtin_amdgcn_cvt_pk_fp8_f32(128.f * q[2 * 65], 128.f * q[3 * 65], p0, true);
            int p1 = __builtin_amdgcn_cvt_pk_fp8_f32(128.f * q[4 * 65], 128.f * q[5 * 65], 0, false); p1 = __builtin_amdgcn_cvt_pk_fp8_f32(128.f * q[6 * 65], 128.f * q[7 * 65], p1, true);
            *(u32x2*)((unsigned char*)t.WT + (size_t)(t.nd + n) * t.K + t.k0 + 8 * c) = (u32x2){(unsigned)p0, (unsigned)p1}; }
        else { u32x4 o; o.x = pk2(q[0], q[65]); o.y = pk2(q[2 * 65], q[3 * 65]); o.z = pk2(q[4 * 65], q[5 * 65]); o.w = pk2(q[6 * 65], q[7 * 65]);
            *(u32x4*)(t.WT + (size_t)(t.nd + n) * t.K + t.k0 + 8 * c) = o; } }
    LDS_WAIT();
}
__device__ __forceinline__ void transpose_items(const Args& a, lds8* lds, int lane, int wave, int gw, int NGW, int it_lo, int it_hi) {
    LAS float* scr = (LAS float*)(lds + wave * 16640);
    int it = it_lo + gw; if (it >= it_hi) return;
    f32x4 va[16], vb[16]; TItem ia = titem_decode(a, it), ib = ia;
    titem_load(ia, lane, va);
    for (;;) {
        const int itb = it + NGW; const bool hb = itb < it_hi;
        if (hb) { ib = titem_decode(a, itb); titem_load(ib, lane, vb); }
        titem_store(ia, lane, va, scr);
        if (!hb) break;
        const int ita = itb + NGW; const bool ha = ita < it_hi;
        if (ha) { ia = titem_decode(a, ita); titem_load(ia, lane, va); }
        titem_store(ib, lane, vb, scr);
        if (!ha) break;
        it = ita;
    }
}
__device__ __forceinline__ void p0_phase(const Args& a, lds8* lds, int tid, int lane, int wave, int blk, int nblk) {
    {
        LAS float* sc = (LAS float*)lds;
        LAS float* red = sc + 3 * DM;
        for (int i = tid; i < 3 * DM; i += NTHR) { const int c = i >> 11, k = i & (DM - 1); const float v = (c == 0) ? a.in[I_CCTX][k] : a.in[I_C][(c - 1) * DM + k]; sc[i] = siluf(v); }
        __syncthreads();
        const float* wm = a.in[I_WMOD]; float* MOD = (float*)(a.ws + WS_MOD);
        for (int slab = blk; slab < 256; slab += nblk) {
            const int col0 = slab * 48, cq = tid % 12, rg = tid / 12;
            float acc[3][4];
#pragma unroll
            for (int c = 0; c < 3; ++c)
#pragma unroll
                for (int j = 0; j < 4; ++j) acc[c][j] = 0.f;
            if (rg < 42) {
#pragma unroll 7
                for (int k = rg; k < DM; k += 42) { const f32x4 w = *(const f32x4*)(wm + (size_t)k * 12288 + col0 + 4 * cq); const float s0 = sc[k], s1 = sc[DM + k], s2 = sc[2 * DM + k];
#pragma unroll
                    for (int j = 0; j < 4; ++j) { acc[0][j] += s0 * w[j]; acc[1][j] += s1 * w[j]; acc[2][j] += s2 * w[j]; } }
#pragma unroll
                for (int c = 0; c < 3; ++c)
#pragma unroll
                    for (int j = 0; j < 4; ++j) red[(rg * 12 + cq) * 12 + c * 4 + j] = acc[c][j];
            }
            __syncthreads();
            if (tid < 144) { const int c = tid / 48, col = tid % 48; float s = 0.f;
                for (int r = 0; r < 42; ++r) s += red[(r * 12 + (col >> 2)) * 12 + c * 4 + (col & 3)];
                MOD[c * 12288 + col0 + col] = s + a.in[I_BMOD][col0 + col]; }
            __syncthreads();
        }
    }
    {
        bf16_t* WG = (bf16_t*)(a.ws + WS_WG); const float* W = a.in[I_WIN];
        for (int i = blk * NTHR + tid; i < NGATE * DM; i += nblk * NTHR) { const int n = i >> 11, k = i & (DM - 1); const int src = n < 16 ? 3072 + n : 6160 + (n - 16);
            WG[i] = (bf16_t)(pk2(W[(size_t)k * WIN_N + src], 0.f) & 0xffffu); }
    }
    transpose_items(a, lds, lane, wave, blk * 8 + wave, nblk * 8, 0, nblk == 256 ? TI_1 : TI_ALL);
}

__device__ __forceinline__ void p1_phase(const Args& a, lds8* lds, int tid, int lane, int wave, int blk, int nblk) {
    constexpr int URS = 4112;
    bf16_t* U = (bf16_t*)(a.ws + WS_U); const float* MOD = (const float*)(a.ws + WS_MOD); const bf16_t* WG = (const bf16_t*)(a.ws + WS_WG); float* G = (float*)(a.ws + WS_G);
    for (int c = blk; c < 3; c += nblk) { float* mc = (float*)(a.ws + WS_MODC) + c * 3 * DM; const float* md = MOD + c * 12288;
        for (int col = tid; col < DM; col += NTHR) { mc[col] = md[4096 + col] * a.in[I_GPOSTMIX][col]; mc[DM + col] = a.in[I_GPREMLP][col] * (1.f + md[8192 + col]); mc[2 * DM + col] = md[10240 + col] * a.in[I_GPOSTMLP][col]; } }
    for (int rg = blk; rg < NTOK / 32; rg += nblk) {
        for (int rr = 0; rr < 4; ++rr) {
            const int r = 4 * wave + rr, row = 32 * rg + r;
            const f32x4* xr = (const f32x4*)xrow_ptr(a, row) + lane; const float* md = MOD + cond_of(row) * 12288;
            f32x4 v[8], gv[8], sv[8], hv[8];
#pragma unroll
            for (int j = 0; j < 8; ++j) { const int col = 4 * lane + 256 * j; v[j] = xr[64 * j]; gv[j] = *(const f32x4*)(a.in[I_GPREMIX] + col); sv[j] = *(const f32x4*)(md + 2048 + col); hv[j] = *(const f32x4*)(md + col); }
            SBAR0();
            float ss = 0.f;
#pragma unroll
            for (int j = 0; j < 8; ++j) ss += (v[j][0] * v[j][0] + v[j][1] * v[j][1]) + (v[j][2] * v[j][2] + v[j][3] * v[j][3]);
            const float rstd = rsqrtf(wave_sum(ss) * (1.f / DM) + EPS);
#pragma unroll
            for (int j = 0; j < 8; ++j) { const int col = 4 * lane + 256 * j;
                const f32x4 o = v[j] * rstd * gv[j] * (1.f + sv[j]) + hv[j];
                u32x2 w; w.x = pk2(o[0], o[1]); w.y = pk2(o[2], o[3]);
                *(u32x2*)(U + (size_t)row * DM + col) = w; *(LAS u32x2*)(lds + r * URS + col * 2) = w;
                { int p = __builtin_amdgcn_cvt_pk_fp8_f32(o[0], o[1], 0, false); p = __builtin_amdgcn_cvt_pk_fp8_f32(o[2], o[3], p, true); *(int*)(a.ws + WS_U8 + (size_t)row * DM + col) = p; } }
        }
        __syncthreads();
        f32x4 acc[2][3];
#pragma unroll
        for (int mi = 0; mi < 2; ++mi)
#pragma unroll
            for (int ni = 0; ni < 3; ++ni) acc[mi][ni] = (f32x4){0.f, 0.f, 0.f, 0.f};
#pragma unroll 2
        for (int kk = 0; kk < 8; ++kk) { const int kb = 256 * wave + 32 * kk + 8 * (lane >> 4);
            bf16x8 av[2], bv[3];
#pragma unroll
            for (int mi = 0; mi < 2; ++mi) av[mi] = *(const LAS bf16x8*)(lds + (16 * mi + (lane & 15)) * URS + kb * 2);
#pragma unroll
            for (int ni = 0; ni < 3; ++ni) bv[ni] = *(const bf16x8*)(WG + (size_t)(16 * ni + (lane & 15)) * DM + kb);
#pragma unroll
            for (int mi = 0; mi < 2; ++mi)
#pragma unroll
                for (int ni = 0; ni < 3; ++ni) acc[mi][ni] = __builtin_amdgcn_mfma_f32_16x16x32_bf16(av[mi], bv[ni], acc[mi][ni], 0, 0, 0); }
        __syncthreads();
        LAS float* part = (LAS float*)lds;
#pragma unroll
        for (int mi = 0; mi < 2; ++mi)
#pragma unroll
            for (int ni = 0; ni < 3; ++ni)
#pragma unroll
                for (int r = 0; r < 4; ++r) part[wave * 1536 + (16 * mi + 4 * (lane >> 4) + r) * 48 + 16 * ni + (lane & 15)] = acc[mi][ni][r];
        __syncthreads();
        for (int i = tid; i < 1536; i += NTHR) { float s = 0.f;
#pragma unroll
            for (int w = 0; w < 8; ++w) s += part[w * 1536 + i];
            const int rrow = i / 48, n = i % 48; float val;
            if (n < 8) val = s + a.in[I_BIG][n];
            else if (n < 16) { const float x = s + a.in[I_BFG][n - 8]; val = fminf(x, 0.f) - log1pf(expf(-fabsf(x))); }
            else { const float x = s + a.in[I_DTB][n - 16]; val = fmaxf(x, 0.f) + log1pf(expf(-fabsf(x))); }
            G[(size_t)(32 * rg + rrow) * NGATE + n] = val; }
        __syncthreads();
    }
}

__device__ __forceinline__ void p3_phase(const Args& a, int tid, int blk, int nblk) {
    const bf16_t* P = (const bf16_t*)(a.ws + WS_P) + 4096; bf16_t* XC = (bf16_t*)(a.ws + WS_XC);
    const int gt = blk * NTHR + tid, total = nblk * NTHR, ch = gt & 255;
    float w[9][8], bias[8];
#pragma unroll
    for (int t = 0; t < 9; ++t)
#pragma unroll
        for (int e = 0; e < 8; ++e) w[t][e] = a.in[I_CONVW][t * 2048 + 8 * ch + e];
#pragma unroll
    for (int e = 0; e < 8; ++e) bias[e] = a.in[I_CONVB][8 * ch + e];
    for (int tok = gt >> 8; tok < NTOK; tok += total >> 8) {
        float acc[8];
#pragma unroll
        for (int e = 0; e < 8; ++e) acc[e] = bias[e];
        const bool pr = tok < NPR; const int lt = pr ? (tok & 255) : ((tok - NPR) & 2047);
        const int gy = pr ? 0 : (lt >> 6), gx = pr ? lt : (lt & 63), H = pr ? 1 : 32, Wd = pr ? 256 : 64;
        const bf16_t* pc = P + 8 * ch;
        if (pr) {
            u32x4 v[3]; float f[3];
#pragma unroll
            for (int j = 0; j < 3; ++j) { const int xx = gx + j - 1; const bool ok = xx >= 0 && xx < Wd; f[j] = ok ? 1.f : 0.f; v[j] = *(const u32x4*)(pc + (size_t)(ok ? tok + j - 1 : tok) * NPJ); }
#pragma unroll
            for (int j = 0; j < 3; ++j)
#pragma unroll
                for (int q = 0; q < 4; ++q) { acc[2 * q] += (w[3 + j][2 * q] * f[j]) * bflo(v[j][q]); acc[2 * q + 1] += (w[3 + j][2 * q + 1] * f[j]) * bfhi(v[j][q]); }
        } else {
            u32x4 v[9]; float f[9];
#pragma unroll
            for (int i = 0; i < 3; ++i)
#pragma unroll
                for (int j = 0; j < 3; ++j) { const int yy = gy + i - 1, xx = gx + j - 1; const bool ok = yy >= 0 && yy < H && xx >= 0 && xx < Wd; f[i * 3 + j] = ok ? 1.f : 0.f;
                    v[i * 3 + j] = *(const u32x4*)(pc + (size_t)(ok ? tok + (i - 1) * 64 + (j - 1) : tok) * NPJ); }
#pragma unroll
            for (int t = 0; t < 9; ++t)
#pragma unroll
                for (int q = 0; q < 4; ++q) { acc[2 * q] += (w[t][2 * q] * f[t]) * bflo(v[t][q]); acc[2 * q + 1] += (w[t][2 * q + 1] * f[t]) * bfhi(v[t][q]); }
        }
        u32x4 o;
#pragma unroll
        for (int q = 0; q < 4; ++q) o[q] = pk2(siluf(acc[2 * q]), siluf(acc[2 * q + 1]));
        *(u32x4*)(XC + (size_t)tok * DM + 8 * ch) = o;
    }
    {
        const float* G = (const float*)(a.ws + WS_G); float* PRE = (float*)(a.ws + WS_PRE);
        const int lane = tid & 63, gw = blk * 8 + (tid >> 6), NGW = nblk * 8;
        for (int task = gw; task < 2560; task += NGW) {
            const bool ml = task < 512; const int t = ml ? task : task - 512, half = ml ? 256 : 1024;
            const bool smp = t >= half; const int seq = smp ? (t - half) >> 4 : t >> 1, c = smp ? (t - half) & 15 : t & 1, nc = smp ? 16 : 2;
            const int hs = ml ? 4 : 16, hd = seq % hs, dir = (seq / hs) & 1, b = seq / (2 * hs);
            const int tok0 = smp ? NPR + b * 2048 : b * 256, blkc = dir ? nc - 1 - c : c, tb = tok0 + blkc * 128;
            const int r0 = 2 * lane, r1 = 2 * lane + 1; const size_t t0 = (size_t)(tb + (dir ? 127 - r0 : r0)) * NGATE, t1 = (size_t)(tb + (dir ? 127 - r1 : r1)) * NGATE;
            float x0, x1, i0 = 0.f, i1 = 0.f;
            if (ml) { i0 = G[t0 + dir * 4 + hd]; i1 = G[t1 + dir * 4 + hd]; x0 = G[t0 + 8 + dir * 4 + hd]; x1 = G[t1 + 8 + dir * 4 + hd]; }
            else { const float aneg = -expf(a.in[I_ALOG][dir * 16 + hd]); i0 = G[t0 + 16 + dir * 16 + hd]; i1 = G[t1 + 16 + dir * 16 + hd]; x0 = i0 * aneg; x1 = i1 * aneg; }
            const float p1 = x0 + x1; float v = p1;
#pragma unroll
            for (int o = 1; o < 64; o <<= 1) { const float tt = __shfl_up(v, o); if (lane >= o) v += tt; }
            const float ex = v - p1, b0 = ex + x0, b1 = ex + p1;
            if (ml) { const float a0 = i0 - b0, a1 = i1 - b1; float w = fmaxf(a0, a1);
#pragma unroll
                for (int o = 1; o < 64; o <<= 1) { const float tt = __shfl_up(w, o); if (lane >= o) w = fmaxf(w, tt); }
                float wp = __shfl_up(w, 1); if (lane == 0) wp = -INFINITY;
                float* p = PRE + (size_t)task * 384;
                *(f32x2_t*)(p + r0) = (f32x2_t){a0, a1}; *(f32x2_t*)(p + 128 + r0) = (f32x2_t){b0, b1}; *(f32x2_t*)(p + 256 + r0) = (f32x2_t){fmaxf(wp, a0), w};
            } else { float* p = PRE + PRE_SSD_OFF + (size_t)t * 256;
                *(f32x2_t*)(p + r0) = (f32x2_t){b0, b1}; *(f32x2_t*)(p + 128 + r0) = (f32x2_t){i0, i1}; }
        }
    }
}

constexpr int RS = 288;
constexpr int RSV = 160;
constexpr int L_Q = 0, L_K = 128 * RS, L_S = 2 * 128 * RS, L_V = 3 * 128 * RS, L_ST = L_V + 128 * RSV, L_VEC = L_ST + 80 * RS;
static_assert(L_VEC + 8 * 128 * 4 <= LDS_BYTES - 64, "scan LDS map");
#define MFMA16(a, b, c) __builtin_amdgcn_mfma_f32_16x16x32_bf16(a, b, c, 0, 0, 0)

template <bool ML>
__device__ __forceinline__ void scan_unit(const Args& a, lds8* lds, const bool sample, const int u, const int tid, const int lane, const int wave) {
    constexpr int EB = ML ? 5 : 4;
    const int sl = ML ? (u & 3) : 0, hd = ML ? ((u >> 2) & 3) : (u & 15), dir = (u >> 4) & 1, b = u >> 5;
    const int tok0 = sample ? NPR + b * 2048 : b * 256, nc = sample ? 16 : 2;
    const bf16_t* Pw = (const bf16_t*)(a.ws + WS_P); const bf16_t* XC = (const bf16_t*)(a.ws + WS_XC);
    const bf16_t *srcQ, *srcK, *srcV; int pitch; bf16_t* outp;
    if (ML) { srcQ = Pw + hd * 128; srcK = Pw + 512 + hd * 128; srcV = Pw + 1024 + hd * 256 + sl * 64; pitch = NPJ;
              outp = (bf16_t*)(a.ws + WS_HY) + (size_t)dir * HY_STRIDE + hd * 256 + sl * 64; }
    else { const int g = hd >> 2; srcQ = XC + 1536 + g * 128; srcK = XC + 1024 + g * 128; srcV = XC + hd * 64; pitch = DM;
           outp = (bf16_t*)(a.ws + WS_HY) + (size_t)(2 + dir) * HY_STRIDE + hd * 64; }
    LAS float* VEC = (LAS float*)(lds + L_VEC);
    LAS float *RA = VEC, *CA = VEC + 128, *CM = VEC + 256, *IS = VEC + 384, *WK = VEC + 512, *DN = VEC + 640, *SC = VEC + 768;
    const int fr = lane & 15, fq = lane >> 4;
    const float qs = 0.08838834764831845f;

    f32x4 st[EB]; float m = 0.f;
#pragma unroll
    for (int eb = 0; eb < EB; ++eb) st[eb] = (f32x4){0.f, 0.f, 0.f, 0.f};
    if (sample) {
        const int sidx = (b * 2 + dir) * (ML ? 4 : 16) + hd;
        if (ML) { const float* cb = a.in[I_SC] + (size_t)sidx * 32768;
#pragma unroll
            for (int eb = 0; eb < 4; ++eb)
#pragma unroll
                for (int r = 0; r < 4; ++r) st[eb][r] = cb[(16 * wave + 4 * fq + r) * 256 + sl * 64 + 16 * eb + fr];
            if (fr == 0) {
#pragma unroll
                for (int r = 0; r < 4; ++r) st[EB - 1][r] = a.in[I_SN][sidx * 128 + 16 * wave + 4 * fq + r]; }
            m = a.in[I_SM][sidx];
        } else { const float* sb = a.in[I_SS] + (size_t)sidx * 8192;
#pragma unroll
            for (int eb = 0; eb < 4; ++eb) st[eb] = *(const f32x4*)(sb + (16 * eb + fr) * 128 + 16 * wave + 4 * fq); }
    }
    __syncthreads();
#pragma unroll
    for (int eb = 0; eb < EB; ++eb) { u32x2 w; w.x = pk2(st[eb][0], st[eb][1]); w.y = pk2(st[eb][2], st[eb][3]);
        *(LAS u32x2*)(lds + L_ST + (16 * eb + fr) * RS + (16 * wave + 4 * fq) * 2) = w; }
    if (tid < 256) { const int row = tid >> 1, hf = tid & 1;
        *(LAS u32x4*)(lds + L_V + row * RSV + 128 + 16 * hf) = (u32x4){(ML && hf == 0) ? 0x00003f80u : 0u, 0u, 0u, 0u}; }

    u32x4 rq[4], rk[4], rv[2]; float pv[5];
#define TROW(r) (dir ? 127 - (r) : (r))
    unsigned oq[4], ov[2];
#pragma unroll
    for (int i = 0; i < 4; ++i) { const int it = tid + NTHR * i, r = it >> 4, chn = it & 15; oq[i] = (unsigned)(TROW(r) * pitch + 8 * chn) * 2u; }
#pragma unroll
    for (int i = 0; i < 2; ++i) { const int it = tid + NTHR * i, r = it >> 3, chn = it & 7; ov[i] = (unsigned)(TROW(r) * pitch + 8 * chn) * 2u; }
    const int pseq = (b * 2 + dir) * (ML ? 4 : 16) + hd;
    const float* pre0 = (const float*)(a.ws + WS_PRE) + (ML ? (size_t)(sample ? 256 + pseq * 16 : pseq * 2) * 384 : PRE_SSD_OFF + (size_t)(sample ? 1024 + pseq * 16 : pseq * 2) * 256);
#define ISSUE_LOADS(c) do { const int _blkc = dir ? nc - 1 - (c) : (c); const size_t _tb = (size_t)(tok0 + _blkc * 128); \
        const char* _bq = (const char*)(srcQ + _tb * pitch); const char* _bk = (const char*)(srcK + _tb * pitch); const char* _bv = (const char*)(srcV + _tb * pitch); \
        _Pragma("unroll") for (int _i = 0; _i < 4; ++_i) { rq[_i] = *(const u32x4*)(_bq + oq[_i]); rk[_i] = *(const u32x4*)(_bk + oq[_i]); } \
        rv[0] = *(const u32x4*)(_bv + ov[0]); rv[1] = *(const u32x4*)(_bv + ov[1]); \
        if (tid < 128) { const float* _p = pre0 + (size_t)(c) * (ML ? 384 : 256); pv[0] = _p[tid]; pv[1] = _p[128 + tid]; pv[2] = ML ? _p[256 + tid] : _p[127]; pv[3] = ML ? _p[256 + 127] : 0.f; pv[4] = ML ? _p[128 + 127] : 0.f; } \
    } while (0)
    ISSUE_LOADS(0);

#pragma unroll 1
    for (int c = 0; c < nc; ++c) {
        const int blkc = dir ? nc - 1 - c : c; const int tb = tok0 + blkc * 128;
        int tidv = tid, frv = fr, fqv = fq; asm volatile("" : "+v"(tidv), "+v"(frv), "+v"(fqv));
#pragma unroll
        for (int i = 0; i < 4; ++i) { const int it = tidv + NTHR * i, r = it >> 4, chn = it & 15; *(LAS u32x4*)(lds + L_Q + r * RS + 16 * chn) = rq[i]; *(LAS u32x4*)(lds + L_K + r * RS + 16 * chn) = rk[i]; }
#pragma unroll
        for (int i = 0; i < 2; ++i) { const int it = tidv + NTHR * i, r = it >> 3, chn = it & 7; *(LAS u32x4*)(lds + L_V + r * RSV + 16 * chn) = rv[i]; }
        if (tidv < 128) {
            if (ML) { const float av = pv[0], bv = pv[1], M = fmaxf(m, pv[2]), Ml = fmaxf(m, pv[3]);
                RA[tidv] = -M; CA[tidv] = av; CM[tidv] = qs; IS[tidv] = qs * __expf(m - M); WK[tidv] = __expf(av - Ml); DN[tidv] = __expf(-(bv + M));
                if (tidv == 0) { SC[0] = __expf(m - Ml); SC[1] = pv[4] + Ml; }
            } else { const float cs = pv[0], dtv = pv[1], tot = pv[2];
                RA[tidv] = cs; CA[tidv] = -cs; CM[tidv] = dtv; IS[tidv] = __expf(cs); WK[tidv] = __expf(tot - cs) * dtv;
                if (tidv == 0) { SC[0] = __expf(tot); SC[1] = 0.f; } }
        }
        if (c + 1 < nc) ISSUE_LOADS(c + 1);
        __syncthreads();
        const float decay = SC[0], m_next = SC[1];
        const int t_w = 16 * wave + frv;
#define SB() __builtin_amdgcn_sched_barrier(0)
#define LDF(off) (*(const LAS bf16x8*)(lds + (off)))
#define KO(kk) ((32 * (kk) + 8 * fqv) * 2)
        f32x4 ah[EB];
#pragma unroll
        for (int eb = 0; eb < EB; ++eb) ah[eb] = (f32x4){0.f, 0.f, 0.f, 0.f};
        f32x4 as[2][4];
        const int sb0 = 2 * (wave >> 1), tb0 = 4 * (wave & 1);
#pragma unroll
        for (int i = 0; i < 2; ++i)
#pragma unroll
            for (int j = 0; j < 4; ++j) as[i][j] = (f32x4){0.f, 0.f, 0.f, 0.f};
        bf16x8 fb[2], fa[2][EB];
        bf16x8 gk[2][2], gq[2][4];
        const int oq_t = L_Q + t_w * RS, ost = L_ST + frv * RS, ok1 = L_K + (16 * sb0 + frv) * RS, oq1 = L_Q + (16 * tb0 + frv) * RS;
#define L3(bf, kk) do { fb[bf] = LDF(oq_t + KO(kk)); _Pragma("unroll") for (int eb = 0; eb < EB; ++eb) fa[bf][eb] = LDF(ost + 16 * eb * RS + KO(kk)); } while (0)
#define M3(bf) do { _Pragma("unroll") for (int eb = 0; eb < EB; ++eb) ah[eb] = MFMA16(fa[bf][eb], fb[bf], ah[eb]); } while (0)
#define L1(bf, kk) do { _Pragma("unroll") for (int i = 0; i < 2; ++i) gk[bf][i] = LDF(ok1 + 16 * i * RS + KO(kk)); _Pragma("unroll") for (int j = 0; j < 4; ++j) gq[bf][j] = LDF(oq1 + 16 * j * RS + KO(kk)); } while (0)
#define M1(bf) do { _Pragma("unroll") for (int i = 0; i < 2; ++i) _Pragma("unroll") for (int j = 0; j < 4; ++j) as[i][j] = MFMA16(gk[bf][i], gq[bf][j], as[i][j]); } while (0)
        const float isv = IS[t_w];
        L3(0, 0); SB();
        L3(1, 1); SB(); M3(0); SB();
        L3(0, 2); SB(); M3(1); SB();
        L3(1, 3); SB(); M3(0); SB();
        L1(0, 0); SB(); M3(1); SB();
#pragma unroll
        for (int eb = 0; eb < EB; ++eb) ah[eb] *= isv;
        L1(1, 1); SB(); M1(0); SB();
        L1(0, 2); SB(); M1(1); SB();
        L1(1, 3); SB(); M1(0); SB();
        f32x4 ca[2], cm[2]; float rav[4];
#pragma unroll
        for (int i = 0; i < 2; ++i) { const int s0 = 16 * (sb0 + i) + 4 * fqv; ca[i] = *(const LAS f32x4*)(CA + s0); cm[i] = *(const LAS f32x4*)(CM + s0); }
#pragma unroll
        for (int j = 0; j < 4; ++j) rav[j] = RA[16 * (tb0 + j) + frv];
        SB(); M1(1); SB();
#pragma unroll
        for (int i = 0; i < 2; ++i) { const int s0 = 16 * (sb0 + i) + 4 * fqv;
#pragma unroll
            for (int j = 0; j < 4; ++j) { const int t = 16 * (tb0 + j) + frv; float val[4];
#pragma unroll
                for (int r = 0; r < 4; ++r) { const float wgt = (s0 + r <= t) ? __expf(rav[j] + ca[i][r]) * cm[i][r] : 0.f; val[r] = as[i][j][r] * wgt; }
                u32x2 w; w.x = pk2(val[0], val[1]); w.y = pk2(val[2], val[3]);
                *(LAS u32x2*)(lds + L_S + t * RS + s0 * 2) = w; } }
        __syncthreads();
        typedef short v4i16_t __attribute__((ext_vector_type(4)));
#define TRF(off) __builtin_shufflevector(__builtin_amdgcn_ds_read_tr16_b64_v4i16((LAS v4i16_t*)(lds + (off))), __builtin_amdgcn_ds_read_tr16_b64_v4i16((LAS v4i16_t*)(lds + (off) + 4 * TRS)), 0, 1, 2, 3, 4, 5, 6, 7)
        const int trq = (8 * fqv + (frv >> 2)), trp = 8 * (frv & 3);
        const int os_t = L_S + t_w * RS, ovt = L_V + trq * RSV + trp, okt = L_K + trq * RS + trp + 32 * wave;
        u32x4 hk[2]; f32x4 hw[2][2];
#define L2(bf, kk) do { fb[bf] = LDF(os_t + KO(kk)); { constexpr int TRS = RSV; _Pragma("unroll") for (int eb = 0; eb < EB; ++eb) fa[bf][eb] = TRF(ovt + 32 * (kk) * RSV + 32 * eb); } } while (0)
#define L4(bf, kk) do { { constexpr int TRS = RS; hk[bf] = __builtin_bit_cast(u32x4, TRF(okt + 32 * (kk) * RS)); } hw[bf][0] = *(const LAS f32x4*)(WK + 32 * (kk) + 8 * fqv); hw[bf][1] = *(const LAS f32x4*)(WK + 32 * (kk) + 8 * fqv + 4); \
            { constexpr int TRS = RSV; _Pragma("unroll") for (int eb = 0; eb < EB; ++eb) fa[bf][eb] = TRF(ovt + 32 * (kk) * RSV + 32 * eb); } } while (0)
#define M4(bf) do { u32x4 ks; ks.x = pk2(bflo(hk[bf].x) * hw[bf][0][0], bfhi(hk[bf].x) * hw[bf][0][1]); ks.y = pk2(bflo(hk[bf].y) * hw[bf][0][2], bfhi(hk[bf].y) * hw[bf][0][3]); \
            ks.z = pk2(bflo(hk[bf].z) * hw[bf][1][0], bfhi(hk[bf].z) * hw[bf][1][1]); ks.w = pk2(bflo(hk[bf].w) * hw[bf][1][2], bfhi(hk[bf].w) * hw[bf][1][3]); \
            const bf16x8 av = __builtin_bit_cast(bf16x8, ks); _Pragma("unroll") for (int eb = 0; eb < EB; ++eb) st[eb] = MFMA16(av, fa[bf][eb], st[eb]); } while (0)
        L2(0, 0); SB();
#pragma unroll
        for (int eb = 0; eb < EB; ++eb) st[eb] *= decay;
        L2(1, 1); SB(); M3(0); SB();
        L2(0, 2); SB(); M3(1); SB();
        L2(1, 3); SB(); M3(0); SB();
        L4(0, 0); SB(); M3(1); SB();
        L4(1, 1); SB(); M4(0); SB();
        { float inv = 1.f;
          if (ML) { const float den = __shfl(ah[EB - 1][0], frv); inv = 1.f / fmaxf(fabsf(den), DN[t_w]); }
          bf16_t* op = outp + (size_t)(tb + TROW(t_w)) * 1024 + 4 * fqv;
#pragma unroll
          for (int eb = 0; eb < 4; ++eb) { u32x2 w; w.x = pk2(ah[eb][0] * inv, ah[eb][1] * inv); w.y = pk2(ah[eb][2] * inv, ah[eb][3] * inv); *(u32x2*)(op + 16 * eb) = w; } }
        L4(0, 2); SB(); M4(1); SB();
        L4(1, 3); SB(); M4(0); SB();
        M4(1);
#pragma unroll
        for (int eb = 0; eb < EB; ++eb) { u32x2 w; w.x = pk2(st[eb][0], st[eb][1]); w.y = pk2(st[eb][2], st[eb][3]);
            *(LAS u32x2*)(lds + L_ST + (16 * eb + frv) * RS + (16 * wave + 4 * fqv) * 2) = w; }
#undef L1
#undef L2
#undef L3
#undef L4
#undef M1
#undef M3
#undef M4
#undef TRF
#undef SB
#undef LDF
#undef KO
        m = m_next;
        __syncthreads();
    }
    if (!sample) {
        float* out = a.out;
        if (ML) { const int sidx = (b * 2 + dir) * 4 + hd;
#pragma unroll
            for (int eb = 0; eb < 4; ++eb)
#pragma unroll
                for (int r = 0; r < 4; ++r) out[O_C + (size_t)sidx * 32768 + (16 * wave + 4 * fq + r) * 256 + sl * 64 + 16 * eb + fr] = st[eb][r];
            if (sl == 0) { if (fr == 0) {
#pragma unroll
                for (int r = 0; r < 4; ++r) out[O_N + sidx * 128 + 16 * wave + 4 * fq + r] = st[EB - 1][r]; }
                if (tid == 0) out[O_M + sidx] = m; }
        } else { const int sidx = (b * 2 + dir) * 16 + hd;
#pragma unroll
            for (int eb = 0; eb < 4; ++eb) *(f32x4*)(out + O_S + (size_t)sidx * 8192 + (16 * eb + fr) * 128 + 16 * wave + 4 * fq) = st[eb]; }
    }
#undef ISSUE_LOADS
#undef TROW
}

constexpr int CW_SQUEUE = 3584;
__device__ __forceinline__ void p4_phase(const Args& a, lds8* lds, int tid, int lane, int wave, int blk, int nblk) {
    const bool split = (nblk == 256);
    constexpr int NSCAN = 208, NCOPY = 48;
    if (split && blk >= NSCAN) { transpose_items(a, lds, lane, wave, (blk - NSCAN) * 8 + wave, NCOPY * 8, TI_1, TI_ALL); return; }
    volatile LAS unsigned* qslot = (volatile LAS unsigned*)(lds + LDS_BYTES - 32);
    unsigned* qcnt = (unsigned*)(a.ws + WS_CTL) + CW_SQUEUE;
    bool long_pending = split && blk < 128; int vb = blk, i = 0;
    for (;;) {
        bool lng, ml; int u;
        if (split) {
            if (long_pending) { long_pending = false; lng = true; ml = blk < 64; u = blk & 63; }
            else {
                __syncthreads();
                if (tid == 0) qslot[0] = xb_add(qcnt, 1u);
                __syncthreads();
                const int sid = (int)qslot[0];
                if (sid >= 1024) break;
                lng = false; ml = (sid & 1) != 0; u = sid >> 1; }
        } else {
            if (vb >= 256) break;
            lng = vb < 128; const int n = lng ? 1 : 8, sid = (vb - 128) * 8 + i; ml = lng ? (vb < 64) : ((sid & 1) != 0); u = lng ? (vb & 63) : (sid >> 1);
            if (++i >= n) { i = 0; vb += nblk; }
        }
        if (ml) scan_unit<true>(a, lds, lng, u, tid, lane, wave); else scan_unit<false>(a, lds, lng, u, tid, lane, wave);
    }
}

__device__ __forceinline__ void ld16bf(const bf16_t* p, float* f) { const u32x4 a = *(const u32x4*)p, b = *(const u32x4*)(p + 8);
#pragma unroll
    for (int q = 0; q < 4; ++q) { f[2 * q] = bflo(a[q]); f[2 * q + 1] = bfhi(a[q]); f[8 + 2 * q] = bflo(b[q]); f[8 + 2 * q + 1] = bfhi(b[q]); } }
__device__ __forceinline__ void st16f8(unsigned char* p, const float* f) { u32x4 w;
#pragma unroll
    for (int q = 0; q < 4; ++q) { int t = __builtin_amdgcn_cvt_pk_fp8_f32(f[4 * q], f[4 * q + 1], 0, false); t = __builtin_amdgcn_cvt_pk_fp8_f32(f[4 * q + 2], f[4 * q + 3], t, true); w[q] = (unsigned)t; }
    *(u32x4*)p = w; }
__device__ __forceinline__ void st16bf(bf16_t* p, const float* f) { u32x4 a, b;
#pragma unroll
    for (int q = 0; q < 4; ++q) { a[q] = pk2(f[2 * q], f[2 * q + 1]); b[q] = pk2(f[8 + 2 * q], f[8 + 2 * q + 1]); }
    *(u32x4*)p = a; *(u32x4*)(p + 8) = b; }
__device__ __forceinline__ void cv16(const u32x4& a, const u32x4& b, float* f) {
#pragma unroll
    for (int q = 0; q < 4; ++q) { f[2 * q] = bflo(a[q]); f[2 * q + 1] = bfhi(a[q]); f[8 + 2 * q] = bflo(b[q]); f[8 + 2 * q + 1] = bfhi(b[q]); } }
__device__ __forceinline__ void p5_phase(const Args& a, int lane, int wave, int blk, int nblk) {
    const bf16_t* P = (const bf16_t*)(a.ws + WS_P); const bf16_t* XC = (const bf16_t*)(a.ws + WS_XC); const bf16_t* HY = (const bf16_t*)(a.ws + WS_HY); bf16_t* A2 = (bf16_t*)(a.ws + WS_U);
    const int c0 = 16 * lane, NGW = nblk * 8;
    float gml[16], gss[16];
#pragma unroll
    for (int i = 0; i < 4; ++i) { const f32x4 g = *(const f32x4*)(a.in[I_GML] + c0 + 4 * i), h = *(const f32x4*)(a.in[I_GSSD] + c0 + 4 * i);
#pragma unroll
        for (int j = 0; j < 4; ++j) { gml[4 * i + j] = g[j]; gss[4 * i + j] = h[j]; } }
    const float dsk = a.in[I_DSKIP][c0 >> 6];
    for (int row0 = blk * 8 + wave; row0 < NTOK; row0 += 2 * NGW) {
        u32x4 L[2][14];
#pragma unroll
        for (int q = 0; q < 2; ++q) { const int row = row0 + q * NGW; if (row < NTOK) {
            const bf16_t* hp = HY + (size_t)row * 1024 + c0; const bf16_t* pp = P + (size_t)row * NPJ + c0; const bf16_t* xp = XC + (size_t)row * DM + c0;
#pragma unroll
            for (int d = 0; d < 4; ++d) { L[q][2 * d] = *(const u32x4*)(hp + d * HY_STRIDE); L[q][2 * d + 1] = *(const u32x4*)(hp + d * HY_STRIDE + 8); }
            L[q][8] = *(const u32x4*)(pp + 2048); L[q][9] = *(const u32x4*)(pp + 2048 + 8); L[q][10] = *(const u32x4*)(pp + 3072); L[q][11] = *(const u32x4*)(pp + 3072 + 8);
            L[q][12] = *(const u32x4*)xp; L[q][13] = *(const u32x4*)(xp + 8); } }
        SBAR0();
#pragma unroll
        for (int q = 0; q < 2; ++q) { const int row = row0 + q * NGW; if (row < NTOK) {
            float h[16], t[16], o[16];
            cv16(L[q][0], L[q][1], h); cv16(L[q][2], L[q][3], t); cv16(L[q][8], L[q][9], o);
            float ss = 0.f;
#pragma unroll
            for (int i = 0; i < 16; ++i) { h[i] += t[i]; ss += h[i] * h[i]; }
            ss += __shfl_xor(ss, 1); ss += __shfl_xor(ss, 2); ss += __shfl_xor(ss, 4); ss += __shfl_xor(ss, 8);
            float rstd = rsqrtf(ss * (1.f / 256.f) + EPS);
#pragma unroll
            for (int i = 0; i < 16; ++i) h[i] = h[i] * rstd * gml[i] * sigmf(o[i]);
            st16f8((unsigned char*)A2 + (size_t)row * DM + c0, h);
            cv16(L[q][4], L[q][5], h); cv16(L[q][6], L[q][7], t); cv16(L[q][12], L[q][13], o);
#pragma unroll
            for (int i = 0; i < 16; ++i) h[i] = h[i] + t[i] + dsk * o[i];
            cv16(L[q][10], L[q][11], o);
            ss = 0.f;
#pragma unroll
            for (int i = 0; i < 16; ++i) { h[i] *= siluf(o[i]); ss += h[i] * h[i]; }
            rstd = rsqrtf(wave_sum(ss) * (1.f / 1024.f) + EPS);
#pragma unroll
            for (int i = 0; i < 16; ++i) h[i] = h[i] * rstd * gss[i];
            st16f8((unsigned char*)A2 + (size_t)row * DM + 1024 + c0, h); } }
    }
}

__device__ __forceinline__ void p7_phase(const Args& a, int lane, int wave, int blk, int nblk) {
    const bf16_t* MIX = (const bf16_t*)(a.ws + WS_MIX); const float* MOD = (const float*)(a.ws + WS_MOD); const float* MODC = (const float*)(a.ws + WS_MODC);
    bf16_t* U = (bf16_t*)(a.ws + WS_U); bf16_t* X1 = (bf16_t*)(a.ws + WS_X1);
    for (int row = blk * 8 + wave; row < NTOK; row += nblk * 8) {
        const u32x2* mr = (const u32x2*)(MIX + (size_t)row * DM) + lane; const f32x4* xr = (const f32x4*)xrow_ptr(a, row) + lane;
        const int cnd = cond_of(row); const float* mc = MODC + cnd * 3 * DM; const float* sh2 = MOD + cnd * 12288 + 6144;
        u32x2 mw[8]; f32x4 xv[8], dv[8], bv[8], cv[8];
#pragma unroll
        for (int j = 0; j < 8; ++j) { const int col = 4 * lane + 256 * j; mw[j] = mr[64 * j]; xv[j] = xr[64 * j]; dv[j] = *(const f32x4*)(mc + col); bv[j] = *(const f32x4*)(mc + DM + col); cv[j] = *(const f32x4*)(sh2 + col); }
        SBAR0();
        f32x4 v[8]; float ss = 0.f;
#pragma unroll
        for (int j = 0; j < 8; ++j) { const u32x2 w = mw[j]; v[j] = (f32x4){bflo(w.x), bfhi(w.x), bflo(w.y), bfhi(w.y)}; ss += (v[j][0] * v[j][0] + v[j][1] * v[j][1]) + (v[j][2] * v[j][2] + v[j][3] * v[j][3]); }
        float rstd = rsqrtf(wave_sum(ss) * (1.f / DM) + EPS); ss = 0.f;
#pragma unroll
        for (int j = 0; j < 8; ++j) { const int col = 4 * lane + 256 * j;
            v[j] = xv[j] + dv[j] * (v[j] * rstd);
            { u32x2 w; w.x = pk2(v[j][0], v[j][1]); w.y = pk2(v[j][2], v[j][3]); *(u32x2*)(X1 + (size_t)row * DM + col) = w; }
            ss += (v[j][0] * v[j][0] + v[j][1] * v[j][1]) + (v[j][2] * v[j][2] + v[j][3] * v[j][3]); }
        rstd = rsqrtf(wave_sum(ss) * (1.f / DM) + EPS);
#pragma unroll
        for (int j = 0; j < 8; ++j) { const int col = 4 * lane + 256 * j;
            const f32x4 o = v[j] * rstd * bv[j] + cv[j];
            int p = __builtin_amdgcn_cvt_pk_fp8_f32(o[0], o[1], 0, false); p = __builtin_amdgcn_cvt_pk_fp8_f32(o[2], o[3], p, true);
            *(int*)((unsigned char*)U + (size_t)row * DM + col) = p; }
    }
}
__device__ __forceinline__ void p10_phase(const Args& a, int lane, int wave, int blk, int nblk) {
    const bf16_t* MO = (const bf16_t*)(a.ws + WS_MIX); const bf16_t* X1 = (const bf16_t*)(a.ws + WS_X1); const float* MODC = (const float*)(a.ws + WS_MODC);
    const int NGW = nblk * 8;
    for (int row0 = blk * 8 + wave; row0 < NTOK; row0 += 2 * NGW) {
        u32x2 mw[2][8], xw[2][8]; f32x4 ev[2][8];
#pragma unroll
        for (int q = 0; q < 2; ++q) { const int row = row0 + q * NGW; if (row < NTOK) {
            const u32x2* mr = (const u32x2*)(MO + (size_t)row * DM) + lane; const u32x2* x1r = (const u32x2*)(X1 + (size_t)row * DM) + lane; const float* mc = MODC + cond_of(row) * 3 * DM + 2 * DM;
#pragma unroll
            for (int j = 0; j < 8; ++j) { mw[q][j] = mr[64 * j]; xw[q][j] = x1r[64 * j]; ev[q][j] = *(const f32x4*)(mc + 4 * lane + 256 * j); } } }
        SBAR0();
#pragma unroll
        for (int q = 0; q < 2; ++q) { const int row = row0 + q * NGW; if (row < NTOK) {
            f32x4* yr = (f32x4*)(a.out + O_Y + (size_t)row * DM) + lane;
            f32x4 v[8]; float ss = 0.f;
#pragma unroll
            for (int j = 0; j < 8; ++j) { const u32x2 w = mw[q][j]; v[j] = (f32x4){bflo(w.x), bfhi(w.x), bflo(w.y), bfhi(w.y)}; ss += (v[j][0] * v[j][0] + v[j][1] * v[j][1]) + (v[j][2] * v[j][2] + v[j][3] * v[j][3]); }
            const float rstd = rsqrtf(wave_sum(ss) * (1.f / DM) + EPS);
#pragma unroll
            for (int j = 0; j < 8; ++j) { const u32x2 w = xw[q][j]; const f32x4 x1 = (f32x4){bflo(w.x), bfhi(w.x), bflo(w.y), bfhi(w.y)};
                yr[64 * j] = x1 + ev[q][j] * (v[j] * rstd); } } }
    }
}

#ifndef PH_MASK
#define PH_MASK 0x7ff
#endif
#define RUN(k) if constexpr (((PH_MASK) >> (k)) & 1)
#define GRID_SYNC() xcd_barrier(bar)
__global__ void __launch_bounds__(NTHR, 2) fwd_kernel(Args a) {
    extern __shared__ __attribute__((aligned(16))) unsigned char lds_raw[];
    lds8* lds = (lds8*)lds_raw;
    cg::grid_group grid = cg::this_grid();
    const int blk = blockIdx.x, nblk = gridDim.x;
#define FRESH() int tid = threadIdx.x; asm volatile("" : "+v"(tid)); const int lane = tid & 63, wave = __builtin_amdgcn_readfirstlane(tid >> 6); (void)lane; (void)wave

    volatile LAS unsigned* bst = (volatile LAS unsigned*)(lds + LDS_BYTES - 64);
    if (threadIdx.x < 2) bst[threadIdx.x] = 0u;
    unsigned* barw = (unsigned*)(a.ws + WS_CTL);
    if (a.ws == nullptr) grid.sync();
    __syncthreads();
    const XcdBarrier bar = xcd_barrier_post(barw, bst);
    RUN(0) { FRESH(); p0_phase(a, lds, tid, lane, wave, blk, nblk); }
    GRID_SYNC();
    RUN(1) { FRESH(); p1_phase(a, lds, tid, lane, wave, blk, nblk); }
    GRID_SYNC();
    RUN(2) {
        { pg8::Gemm g{(const pg8::bf16_t*)(a.ws + WS_U), (const pg8::bf16_t*)(a.ws + WS_WIN), NTOK, NPJ, DM}; pg8::SkipOrder S; S.base.init(NTOK, 16 * 256, nblk, blk); S.skip_from = 8; S.skip_by = 8;
          pg8::EpiBf16<0> E{(pg8::bf16_t*)(a.ws + WS_P), NPJ};
          pg8::gemm_phase<pg8::EpiBf16<0>, pg8::SkipOrder, true, true>(lds, g, S, E); }
        { pg8::Gemm g{(const pg8::bf16_t*)(a.ws + WS_U8), (const pg8::bf16_t*)(a.ws + WS_WIN8), NTOK, 2048, DM / 2}; pg8::StaticOrder S; S.init(NTOK, 2048, nblk, blk);
          pg8::EpiBf16<0> E{(pg8::bf16_t*)(a.ws + WS_P) + 2048, NPJ};
          pg8::gemm_phase<pg8::EpiBf16<0>, pg8::StaticOrder, true, true, true>(lds, g, S, E); }
    }
    GRID_SYNC();
    RUN(3) { FRESH(); p3_phase(a, tid, blk, nblk); }
    GRID_SYNC();
    RUN(4) { FRESH(); p4_phase(a, lds, tid, lane, wave, blk, nblk); }
    GRID_SYNC();
    RUN(5) { FRESH(); p5_phase(a, lane, wave, blk, nblk); }
    GRID_SYNC();
    RUN(6) {
        pg8::Gemm g{(const pg8::bf16_t*)(a.ws + WS_U), (const pg8::bf16_t*)(a.ws + WS_WOUT), NTOK, DM, DM / 2}; pg8::StaticOrder S; S.init(NTOK, DM, nblk, blk);
        pg8::EpiBf16<0> E{(pg8::bf16_t*)(a.ws + WS_MIX), DM};
        pg8::gemm_phase<pg8::EpiBf16<0>, pg8::StaticOrder, true, true, true>(lds, g, S, E);
    }
    GRID_SYNC();
    RUN(7) { FRESH(); p7_phase(a, lane, wave, blk, nblk); }
    GRID_SYNC();
    RUN(8) {
        pg8::Gemm g{(const pg8::bf16_t*)(a.ws + WS_U), (const pg8::bf16_t*)(a.ws + WS_WMI), NTOK, DFF, DM / 2}; pg8::StaticOrder S; S.init(NTOK, DFF, nblk, blk);
        pg8::EpiFp8Relu2 E{a.ws + WS_HDN, DFF};
        pg8::gemm_phase<pg8::EpiFp8Relu2, pg8::StaticOrder, true, true, true>(lds, g, S, E);
    }
    GRID_SYNC();
    RUN(9) {
        pg8::Gemm g{(const pg8::bf16_t*)(a.ws + WS_HDN), (const pg8::bf16_t*)(a.ws + WS_WMO), NTOK, DM, DFF / 2}; pg8::StaticOrder S; S.init(NTOK, DM, nblk, blk);
        pg8::EpiBf16<0> E{(pg8::bf16_t*)(a.ws + WS_MIX), DM};
        pg8::gemm_phase<pg8::EpiBf16<0>, pg8::StaticOrder, true, true, true>(lds, g, S, E);
    }
    GRID_SYNC();
    RUN(10) { FRESH(); p10_phase(a, lane, wave, blk, nblk); }
}

extern "C" void kernel_launch(void* const* d_in, const int* in_sizes, int n_in, void* d_out, int out_size, void* d_ws, size_t ws_size, hipStream_t stream) {
    static int grid = 0;
    if (grid == 0) {
        if (n_in != 27 || ws_size < WS_END) { fprintf(stderr, "kernel_launch: expected 27 inputs and >= %zu bytes of workspace (got %d, %zu)\n", (size_t)WS_END, n_in, ws_size); grid = -1; return; }
        int dev = 0, cus = 0, per_cu = 0;
        hipGetDevice(&dev); hipDeviceGetAttribute(&cus, hipDeviceAttributeMultiprocessorCount, dev);
        if (hipFuncSetAttribute((const void*)fwd_kernel, hipFuncAttributeMaxDynamicSharedMemorySize, LDS_BYTES) != hipSuccess) { fprintf(stderr, "kernel_launch: hipFuncSetAttribute failed\n"); grid = -1; return; }
        if (hipOccupancyMaxActiveBlocksPerMultiprocessor(&per_cu, (const void*)fwd_kernel, NTHR, LDS_BYTES) != hipSuccess || per_cu < 1) { fprintf(stderr, "kernel_launch: occupancy query failed (%d)\n", per_cu); (void)hipGetLastError(); per_cu = 1; }
        grid = cus * (per_cu > 1 ? 1 : per_cu);
        if (grid > 256) grid = 256;
    }
    if (grid < 0) return;
    Args a{};
    for (int i = 0; i < 27; ++i) a.in[i] = (const float*)d_in[i];
    a.out = (float*)d_out; a.ws = (unsigned char*)d_ws;
    if (hipMemsetAsync((char*)d_ws + WS_CTL, 0, 16384, stream) != hipSuccess) { fprintf(stderr, "kernel_launch: memset of the barrier words failed\n"); return; }
    void* args[] = {&a};
    hipError_t e = hipLaunchCooperativeKernel((const void*)fwd_kernel, dim3(grid), dim3(NTHR), args, LDS_BYTES, stream);
    if (e != hipSuccess) fprintf(stderr, "kernel_launch: cooperative launch failed: %s (grid %d)\n", hipGetErrorString(e), grid);
}
```

```cpp
#include <hip/hip_runtime.h>
#include <hip/hip_cooperative_groups.h>
#include <cstdio>
#include <cstdint>
namespace cg = cooperative_groups;
namespace pg8 {
#define PG8_LAS __attribute__((address_space(3)))
typedef unsigned short bf16_t;
typedef short bf16x8 __attribute__((ext_vector_type(8)));
typedef float f32x4 __attribute__((ext_vector_type(4)));
typedef unsigned u32x4 __attribute__((ext_vector_type(4)));
typedef int i32x8 __attribute__((ext_vector_type(8)));
constexpr int BM = 256, BK = 64, HALF = 128, HTB = HALF * BK * 2  , STAGE_BYTES = 8 * HTB, NXCD = 1, WGM = 4;

__host__ __device__ __forceinline__ int lds_byte(int r, int c) { const int st = (r >> 4) * 2 + (c >> 5), rr = r & 15, cc = c & 31, ob = rr * 64 + cc * 2; return st * 1024 + (ob ^ (((ob >> 9) & 1) << 5)); }
__host__ __device__ __forceinline__ void stage_rc(int b, int& R, int& C) { const int st = b / 1024, sb = b % 1024, swz = sb ^ (((sb >> 9) & 1) << 5); R = (st >> 1) * 16 + swz / 64; C = (st & 1) * 32 + (swz % 64) / 2; }
__host__ __device__ __forceinline__ int perm32(int rho) { const int n = rho >> 4, i = rho & 15; return 8 * (i >> 2) + 4 * n + (i & 3); }

struct Unit { int pm, pn; };
struct Gemm { const bf16_t* A; const bf16_t* Bt; int M, N, K; };

struct StaticOrder {
    int nM, nN, nwg, G, c;
    __host__ __device__ void init(int M, int N, int G_, int c_) { nM = M / BM; nN = N / BM; nwg = nM * nN; G = G_; c = c_; }
    __host__ __device__ bool next(int i, Unit& u) const {
        const long L = (long)i * G + c; if (L >= nwg) return false;
        int wgid = (int)L; { const int q = nwg / NXCD, r = nwg % NXCD, xcd = wgid % NXCD, off = wgid / NXCD; wgid = (xcd < r ? xcd * (q + 1) : r * (q + 1) + (xcd - r) * q) + off; }
        const int nig = WGM * nN, gid = wgid / nig, fm = gid * WGM, gsz = (nM - fm) < WGM ? (nM - fm) : WGM;
        u.pm = fm + ((wgid % nig) % gsz); u.pn = (wgid % nig) / gsz; return true;
    }
    __device__ __forceinline__ void a_ready(const Unit&) const {}
    __device__ __forceinline__ void done(const Unit&) const {}
};
struct SkipOrder {
    StaticOrder base; int skip_from, skip_by;
    __host__ __device__ bool next(int i, Unit& u) const { if (!base.next(i, u)) return false; if (u.pn >= skip_from) u.pn += skip_by; return true; }
    __device__ __forceinline__ void a_ready(const Unit&) const {}
    __device__ __forceinline__ void done(const Unit&) const {}
};
__device__ __forceinline__ unsigned cvt_pk_bf16(float lo, float hi) { unsigned r; asm volatile("v_cvt_pk_bf16_f32 %0, %1, %2" : "=v"(r) : "v"(lo), "v"(hi)); return r; }
template <int ACT> struct EpiBf16 {
    static constexpr bool PERM = true, AFTER_DRAIN = false;
    bf16_t* O; int ldc;
    __device__ __forceinline__ void operator()(const f32x4 (&acc)[2][2][4][2], const Unit& u, int wr, int wc, int fr, int fq, bool last) const {
        const int row0 = u.pm * BM + wr * 64 + fr; const int col0 = u.pn * BM + wc * 32 + 8 * fq;
#pragma unroll
        for (int ai = 0; ai < 2; ++ai)
#pragma unroll
            for (int m = 0; m < 4; ++m) { bf16_t* rowp = O + (size_t)(row0 + ai * HALF + m * 16) * ldc + col0;
#pragma unroll
                for (int bj = 0; bj < 2; ++bj) { f32x4 v0 = acc[ai][bj][m][0], v1 = acc[ai][bj][m][1];
                    if (ACT == 1) {
#pragma unroll
                        for (int j = 0; j < 4; ++j) { const float a = fmaxf(v0[j], 0.f), b = fmaxf(v1[j], 0.f); v0[j] = a * a; v1[j] = b * b; } }
                    u32x4 w; w.x = cvt_pk_bf16(v0[0], v0[1]); w.y = cvt_pk_bf16(v0[2], v0[3]); w.z = cvt_pk_bf16(v1[0], v1[1]); w.w = cvt_pk_bf16(v1[2], v1[3]);
                    if (last) asm volatile("global_store_dwordx4 %0, %1, off sc1\n\ts_nop 1" :: "v"(rowp + bj * HALF), "v"(w) : "memory"); else *(u32x4*)(rowp + bj * HALF) = w; } }
    }
};
struct EpiFp8Relu2 {
    static constexpr bool PERM = true, AFTER_DRAIN = false;
    unsigned char* O; int ldc;
    __device__ __forceinline__ void operator()(const f32x4 (&acc)[2][2][4][2], const Unit& u, int wr, int wc, int fr, int fq, bool last) const {
        typedef unsigned u32x2 __attribute__((ext_vector_type(2)));
        const int row0 = u.pm * BM + wr * 64 + fr; const int col0 = u.pn * BM + wc * 32 + 8 * fq;
#pragma unroll
        for (int ai = 0; ai < 2; ++ai)
#pragma unroll
            for (int m = 0; m < 4; ++m) { unsigned char* rowp = O + (size_t)(row0 + ai * HALF + m * 16) * ldc + col0;
#pragma unroll
                for (int bj = 0; bj < 2; ++bj) { f32x4 v0 = acc[ai][bj][m][0], v1 = acc[ai][bj][m][1];
#pragma unroll
                    for (int j = 0; j < 4; ++j) { const float a = fmaxf(v0[j], 0.f), b = fmaxf(v1[j], 0.f); v0[j] = a * a; v1[j] = b * b; }
                    int p0 = __builtin_amdgcn_cvt_pk_fp8_f32(v0[0], v0[1], 0, false); p0 = __builtin_amdgcn_cvt_pk_fp8_f32(v0[2], v0[3], p0, true);
                    int p1 = __builtin_amdgcn_cvt_pk_fp8_f32(v1[0], v1[1], 0, false); p1 = __builtin_amdgcn_cvt_pk_fp8_f32(v1[2], v1[3], p1, true);
                    const u32x2 w = {(unsigned)p0, (unsigned)p1};
                    if (last) asm volatile("global_store_dwordx2 %0, %1, off sc1\n\ts_nop 1" :: "v"(rowp + bj * HALF), "v"(w) : "memory"); else *(u32x2*)(rowp + bj * HALF) = w; } }
    }
};
struct EpiF32 {
    static constexpr bool PERM = false, AFTER_DRAIN = false;
    float* O; int ldc;
    __device__ __forceinline__ void operator()(const f32x4 (&acc)[2][2][4][2], const Unit& u, int wr, int wc, int fr, int fq, bool) const {
        const int row0 = u.pm * BM + wr * 64 + fr; const int col0 = u.pn * BM + wc * 32 + 4 * fq;
#pragma unroll
        for (int ai = 0; ai < 2; ++ai)
#pragma unroll
            for (int m = 0; m < 4; ++m) { float* rowp = O + (size_t)(row0 + ai * HALF + m * 16) * ldc + col0;
#pragma unroll
                for (int bj = 0; bj < 2; ++bj)
#pragma unroll
                    for (int n = 0; n < 2; ++n) *(f32x4*)(rowp + bj * HALF + n * 16) = acc[ai][bj][m][n]; }
    }
};
template <bool F8> struct FragSel { typedef bf16x8 T; static constexpr int KF = 2; };
template <> struct FragSel<true> { typedef i32x8 T; static constexpr int KF = 1; };
template <class Epi, class Sched, bool ALIGN_EPI = false, bool SP2 = false, bool F8 = false>
__device__ __forceinline__ void gemm_phase(PG8_LAS unsigned char* lds, const Gemm g, const Sched& S, const Epi& E) {
    int tid_o = threadIdx.x; asm volatile("" : "+v"(tid_o));
    const int tid = tid_o, wid = __builtin_amdgcn_readfirstlane(tid >> 6), lane = tid & 63, wr = wid >> 2, wc = wid & 3, fr = lane & 15, fq = lane >> 4;
    const int K = g.K, nt = K / BK;
    unsigned voffA[2], voffB[2];
#pragma unroll
    for (int i = 0; i < 2; ++i) { int R, C; stage_rc(tid * 16 + i * 8192, R, C); const int Rb = Epi::PERM ? ((R & ~31) + perm32(R & 31)) : R;
        voffA[i] = (unsigned)(R * K + C) * 2u; voffB[i] = (unsigned)(Rb * K + C) * 2u; }
    const size_t kstep = (size_t)(BK * 2);
    const size_t hstep = (size_t)HALF * K * 2;
    const size_t tstep = 2 * hstep;
    const unsigned ldsw = (unsigned)wid * 1024u;
    const int aoff = lds_byte(wr * 64 + fr, fq * 8), boff = lds_byte(wc * 32 + fr, fq * 8);
#define PG8_SA(b, h) (((b) * 2 + (h)) * HTB)
#define PG8_SB(b, h) ((4 + (b) * 2 + (h)) * HTB)
#define PG8_STAGE(bufoff, gbase, voff) do { _Pragma("unroll") for (int _i = 0; _i < 2; ++_i) \
        __builtin_amdgcn_global_load_lds((const unsigned*)((const char*)(gbase) + (voff)[_i]), (PG8_LAS unsigned*)(lds + (bufoff) + ldsw + _i * 8192), 16, 0, 0); } while (0)
#define PG8_CAT(x, y) __builtin_bit_cast(i32x8, __builtin_shufflevector(x, y, 0, 1, 2, 3, 4, 5, 6, 7, 8, 9, 10, 11, 12, 13, 14, 15))
#define PG8_LDA(dst, b, h) do { _Pragma("unroll") for (int m = 0; m < 4; ++m) { if constexpr (F8) dst[m][0] = PG8_CAT(*(const PG8_LAS bf16x8*)(lds + PG8_SA(b, h) + aoff + m * 2048), *(const PG8_LAS bf16x8*)(lds + PG8_SA(b, h) + aoff + m * 2048 + 1024)); \
        else { _Pragma("unroll") for (int k = 0; k < KF; ++k) dst[m][k] = *(const PG8_LAS frag_t*)(lds + PG8_SA(b, h) + aoff + m * 2048 + k * 1024); } } } while (0)
#define PG8_LDB(dst, b, h) do { _Pragma("unroll") for (int n = 0; n < 2; ++n) { if constexpr (F8) dst[n][0] = PG8_CAT(*(const PG8_LAS bf16x8*)(lds + PG8_SB(b, h) + boff + n * 2048), *(const PG8_LAS bf16x8*)(lds + PG8_SB(b, h) + boff + n * 2048 + 1024)); \
        else { _Pragma("unroll") for (int k = 0; k < KF; ++k) dst[n][k] = *(const PG8_LAS frag_t*)(lds + PG8_SB(b, h) + boff + n * 2048 + k * 1024); } } } while (0)
#define PG8_MMA(ai, bj, At, Bt) do { __builtin_amdgcn_s_setprio(1); _Pragma("unroll") for (int m = 0; m < 4; ++m) _Pragma("unroll") for (int n = 0; n < 2; ++n) { \
        if constexpr (F8) asm volatile("v_mfma_scale_f32_16x16x128_f8f6f4 %0, %1, %2, %0, %3, %4 op_sel_hi:[0,0,0]" : "+v"(acc[ai][bj][m][n]) : "v"(Bt[n][0]), "v"(At[m][0]), "v"(sc_w), "v"(sc_a)); \
        else { _Pragma("unroll") for (int k = 0; k < KF; ++k) acc[ai][bj][m][n] = __builtin_amdgcn_mfma_f32_16x16x32_bf16(Bt[n][k], At[m][k], acc[ai][bj][m][n], 0, 0, 0); } } \
        __builtin_amdgcn_s_setprio(0); } while (0)
#define PG8_WAIT_V(n) asm volatile("s_waitcnt vmcnt(" #n ")" ::: "memory")
#define PG8_WAIT_L(n) asm volatile("s_waitcnt lgkmcnt(" #n ")" ::: "memory")
#define PG8_BAR __builtin_amdgcn_s_barrier()
#define PG8_SCHED __builtin_amdgcn_sched_barrier(0)
    Unit cur, nxt; int ui = 0;
    if (!S.next(0, cur)) return;
    f32x4 acc[2][2][4][2];
#pragma unroll
    for (int a = 0; a < 2; ++a)
#pragma unroll
        for (int b = 0; b < 2; ++b)
#pragma unroll
            for (int m = 0; m < 4; ++m)
#pragma unroll
                for (int n = 0; n < 2; ++n) acc[a][b][m][n] = (f32x4){0.f, 0.f, 0.f, 0.f};
    typedef typename FragSel<F8>::T frag_t; constexpr int KF = FragSel<F8>::KF;
    frag_t At[4][KF], B0[2][KF], B1[2][KF];
    int sc_w = 0x78787878, sc_a = 0x7f7f7f7f; asm volatile("" : "+v"(sc_w), "+v"(sc_a));
    (void)sc_w; (void)sc_a;
    const char* cA = (const char*)g.A + (size_t)cur.pm * tstep; const char* cB = (const char*)g.Bt + (size_t)cur.pn * tstep;
    S.a_ready(cur);
    if constexpr (SP2) {
        PG8_STAGE(PG8_SB(0, 0), cB, voffB); PG8_STAGE(PG8_SB(0, 1), cB + hstep, voffB); PG8_STAGE(PG8_SA(0, 0), cA, voffA); PG8_STAGE(PG8_SA(0, 1), cA + hstep, voffA);
        if (wr == 1) PG8_BAR;
        PG8_WAIT_V(2); PG8_BAR;
        PG8_STAGE(PG8_SB(1, 0), cB + kstep, voffB); PG8_STAGE(PG8_SA(1, 0), cA + kstep, voffA); PG8_STAGE(PG8_SB(1, 1), cB + hstep + kstep, voffB);
        PG8_WAIT_V(6); PG8_BAR;
    } else {
        PG8_STAGE(PG8_SB(0, 0), cB, voffB); PG8_STAGE(PG8_SA(0, 0), cA, voffA); PG8_STAGE(PG8_SB(0, 1), cB + hstep, voffB); PG8_STAGE(PG8_SA(0, 1), cA + hstep, voffA);
        if (wr == 1) PG8_BAR;
        PG8_WAIT_V(4); PG8_BAR;
        PG8_STAGE(PG8_SB(1, 0), cB + kstep, voffB); PG8_STAGE(PG8_SA(1, 0), cA + kstep, voffA); PG8_STAGE(PG8_SB(1, 1), cB + hstep + kstep, voffB);
        PG8_WAIT_V(6); PG8_BAR;
    }
    for (;;) {
        const bool has_next = S.next(ui + 1, nxt);
        const char* nA = has_next ? (const char*)g.A + (size_t)nxt.pm * tstep : cA; const char* nB = has_next ? (const char*)g.Bt + (size_t)nxt.pn * tstep : cB;
        for (int t = 0; t < nt; t += 2) {
            const bool last = (t == nt - 2);
            const char* a1 = cA + (size_t)(t + 1) * kstep;
            const char* a2 = last ? nA : cA + (size_t)(t + 2) * kstep; const char* b2 = last ? nB : cB + (size_t)(t + 2) * kstep;
            const char* a3 = a2 + kstep; const char* b3 = b2 + kstep;
            if (last && has_next) S.a_ready(nxt);
            if constexpr (SP2) {
            PG8_LDB(B0, 0, 0); PG8_LDB(B1, 0, 1); PG8_SCHED; PG8_LDA(At, 0, 0); PG8_STAGE(PG8_SA(1, 1), a1 + hstep, voffA);
            PG8_WAIT_V(8); PG8_WAIT_L(0); PG8_BAR; PG8_MMA(0, 0, At, B0); PG8_MMA(0, 1, At, B1); PG8_BAR; PG8_SCHED;
            PG8_LDA(At, 0, 1); PG8_STAGE(PG8_SB(0, 0), b2, voffB); PG8_STAGE(PG8_SB(0, 1), b2 + hstep, voffB); PG8_STAGE(PG8_SA(0, 0), a2, voffA);
            PG8_WAIT_V(8); PG8_WAIT_L(0); PG8_BAR; PG8_MMA(1, 0, At, B0); PG8_MMA(1, 1, At, B1); PG8_BAR; PG8_SCHED;
            PG8_LDB(B0, 1, 0); PG8_LDB(B1, 1, 1); PG8_SCHED; PG8_LDA(At, 1, 0); PG8_STAGE(PG8_SA(0, 1), a2 + hstep, voffA);
            PG8_WAIT_V(8); PG8_WAIT_L(0); PG8_BAR; PG8_MMA(0, 0, At, B0); PG8_MMA(0, 1, At, B1); PG8_BAR; PG8_SCHED;
            PG8_LDA(At, 1, 1); PG8_STAGE(PG8_SB(1, 0), b3, voffB); PG8_STAGE(PG8_SB(1, 1), b3 + hstep, voffB); PG8_STAGE(PG8_SA(1, 0), a3, voffA);
            PG8_WAIT_V(8); PG8_WAIT_L(0); PG8_BAR; PG8_MMA(1, 0, At, B0); PG8_MMA(1, 1, At, B1); PG8_BAR; PG8_SCHED;
            } else {
            PG8_LDB(B0, 0, 0); PG8_SCHED; PG8_LDA(At, 0, 0); PG8_STAGE(PG8_SA(1, 1), a1 + hstep, voffA);
            PG8_WAIT_L(8); PG8_BAR; PG8_WAIT_L(0); PG8_MMA(0, 0, At, B0); PG8_BAR; PG8_SCHED;
            PG8_LDB(B1, 0, 1); PG8_STAGE(PG8_SB(0, 0), b2, voffB);
            PG8_BAR; PG8_WAIT_L(0); PG8_MMA(0, 1, At, B1); PG8_BAR;
            PG8_LDA(At, 0, 1); PG8_STAGE(PG8_SA(0, 0), a2, voffA);
            PG8_BAR; PG8_WAIT_L(0); PG8_MMA(1, 0, At, B0); PG8_BAR; PG8_SCHED;
            PG8_STAGE(PG8_SB(0, 1), b2 + hstep, voffB);
            PG8_WAIT_V(6); PG8_BAR; PG8_MMA(1, 1, At, B1); PG8_BAR;
            PG8_LDB(B0, 1, 0); PG8_SCHED; PG8_LDA(At, 1, 0); PG8_STAGE(PG8_SA(0, 1), a2 + hstep, voffA);
            PG8_WAIT_L(8); PG8_BAR; PG8_WAIT_L(0); PG8_MMA(0, 0, At, B0); PG8_BAR; PG8_SCHED;
            PG8_LDB(B1, 1, 1); PG8_STAGE(PG8_SB(1, 0), b3, voffB);
            PG8_BAR; PG8_WAIT_L(0); PG8_MMA(0, 1, At, B1); PG8_BAR;
            PG8_LDA(At, 1, 1); PG8_STAGE(PG8_SA(1, 0), a3, voffA);
            PG8_BAR; PG8_WAIT_L(0); PG8_MMA(1, 0, At, B0); PG8_BAR; PG8_SCHED;
            PG8_STAGE(PG8_SB(1, 1), b3 + hstep, voffB);
            PG8_WAIT_V(6); PG8_BAR; PG8_MMA(1, 1, At, B1); PG8_BAR;
            }
        }
        if constexpr (ALIGN_EPI) { if (wr == 0) PG8_BAR; }
        if constexpr (F8) asm volatile("s_nop 7\n\ts_nop 7" ::: "memory");
        if constexpr (!Epi::AFTER_DRAIN) { E(acc, cur, wr, wc, fr, fq, !has_next); S.done(cur); }
        if (!has_next) break;
#pragma unroll
        for (int a = 0; a < 2; ++a)
#pragma unroll
            for (int b = 0; b < 2; ++b)
#pragma unroll
                for (int m = 0; m < 4; ++m)
#pragma unroll
                    for (int n = 0; n < 2; ++n) acc[a][b][m][n] = (f32x4){0.f, 0.f, 0.f, 0.f};
        cur = nxt; cA = nA; cB = nB; ++ui;
        if constexpr (ALIGN_EPI) { if (wr == 1) PG8_BAR; }
    }
    PG8_WAIT_V(0);
    if constexpr (!ALIGN_EPI) { if (wr == 0) PG8_BAR; }
    PG8_BAR;
    if constexpr (Epi::AFTER_DRAIN) { E.fused(acc, cur, wr, wc, fr, fq, lds, wid, lane); S.done(cur); }
#undef PG8_SA
#undef PG8_SB
#undef PG8_STAGE
#undef PG8_LDA
#undef PG8_LDB
#undef PG8_MMA
#undef PG8_WAIT_V
#undef PG8_WAIT_L
#undef PG8_BAR
#undef PG8_SCHED
}
}
#define LAS __attribute__((address_space(3)))
typedef LAS unsigned char lds8;
typedef unsigned short bf16_t;
typedef short bf16x8 __attribute__((ext_vector_type(8)));
typedef float f32x4 __attribute__((ext_vector_type(4)));
typedef unsigned u32x4 __attribute__((ext_vector_type(4)));
typedef unsigned u32x2 __attribute__((ext_vector_type(2)));
typedef float f32x2_t __attribute__((ext_vector_type(2)));
typedef __bf16 bf16x2_t __attribute__((ext_vector_type(2)));

constexpr int DM = 2048, NTOK = 8192, NPR = 4096, DFF = 8192, NPJ = 6144, NGATE = 48, WIN_N = 6192;
constexpr float EPS = 1e-6f;
constexpr int NTHR = 512;
constexpr int LDS_BYTES = 163840;
constexpr size_t MiB = 1u << 20;
constexpr size_t WS_MODC = 1 * MiB + 512 * 1024;
constexpr size_t WS_CTL = 0, WS_MOD = 1 * MiB, WS_G = 2 * MiB, WS_WG = 4 * MiB, WS_WIN = 5 * MiB, WS_WOUT = 29 * MiB, WS_WMI = 37 * MiB, WS_WMO = 69 * MiB,
                 WS_U = 101 * MiB, WS_P = 133 * MiB, WS_XC = 229 * MiB, WS_HDN = 133 * MiB, WS_HY = 261 * MiB, WS_MIX = 261 * MiB, WS_PRE = 325 * MiB, WS_X1 = 329 * MiB, WS_U8 = 361 * MiB, WS_WIN8 = 377 * MiB, WS_END = 381 * MiB;
constexpr size_t HY_STRIDE = (size_t)NTOK * 1024;
constexpr size_t PRE_SSD_OFF = (size_t)512 * 3 * 128;
constexpr size_t O_Y = 0, O_C = 16777216, O_N = O_C + 4194304, O_M = O_N + 16384, O_S = O_M + 128;

struct Args { const float* in[27]; float* out; unsigned char* ws; };
enum { I_XP = 0, I_XS, I_SC, I_SN, I_SM, I_SS, I_C, I_CCTX, I_WMOD, I_BMOD, I_GPREMIX, I_GPOSTMIX, I_WIN, I_BIG, I_BFG, I_CONVW, I_CONVB, I_DTB, I_ALOG, I_DSKIP,
       I_GML, I_GSSD, I_WOUT, I_GPREMLP, I_GPOSTMLP, I_WMI, I_WMO };

__device__ __forceinline__ unsigned pk2(float lo, float hi) { f32x2_t v = {lo, hi}; bf16x2_t b = __builtin_convertvector(v, bf16x2_t); return __builtin_bit_cast(unsigned, b); }
__device__ __forceinline__ float bflo(unsigned w) { return __uint_as_float(w << 16); }
__device__ __forceinline__ float bfhi(unsigned w) { return __uint_as_float(w & 0xffff0000u); }
__device__ __forceinline__ float wave_sum(float v) {
#pragma unroll
    for (int o = 1; o < 64; o <<= 1) v += __shfl_xor(v, o);
    return v;
}
#define LDS_WAIT() asm volatile("s_waitcnt lgkmcnt(0)" ::: "memory")
#define SBAR0() __builtin_amdgcn_sched_barrier(0)
__device__ __forceinline__ const float* xrow_ptr(const Args& a, int row) { return row < NPR ? a.in[I_XP] + (size_t)row * DM : a.in[I_XS] + (size_t)(row - NPR) * DM; }
__device__ __forceinline__ int cond_of(int row) { return row < NPR ? 0 : 1 + ((row - NPR) >> 11); }
__device__ __forceinline__ float siluf(float v) { return v / (1.f + __expf(-v)); }
__device__ __forceinline__ float sigmf(float v) { return 1.f / (1.f + __expf(-v)); }

#define XB_TMO      128
#define XB_XCNT(j)  (256  + 64 * (j))
#define XB_XSUB(j)  (1280 + 64 * (j))
#define XB_XGEN(j)  (2304 + 64 * (j))
#define XB_TOP      3328
#define XB_TOPGEN   3392
#define XCD_BAR_WORDS 3456
#define XB_SPIN_CAP (1u << 18)

__device__ __forceinline__ unsigned xb_ld(unsigned* p)              { return __hip_atomic_load(p, __ATOMIC_RELAXED, __HIP_MEMORY_SCOPE_AGENT); }
__device__ __forceinline__ unsigned xb_add(unsigned* p, unsigned v) { return __hip_atomic_fetch_add(p, v, __ATOMIC_RELAXED, __HIP_MEMORY_SCOPE_AGENT); }
__device__ __forceinline__ unsigned xb_xcc_id() { return (unsigned)__builtin_amdgcn_s_getreg((3 << 11) | 20) & 0xFu; }
#define XB_SPIN(cond, bar) do { unsigned _sp = 0; while (cond) { __builtin_amdgcn_s_sleep(1); \
    if ((++_sp & 255u) == 0u) { if (xb_ld(&(bar)[XB_TMO])) break; if (_sp > XB_SPIN_CAP) { atomicAdd(&(bar)[XB_TMO], 1u); break; } } } } while (0)

struct XcdBarrier {
    unsigned* bar; unsigned x;
    volatile LAS unsigned* st;
};

__device__ __forceinline__ XcdBarrier xcd_barrier_post(unsigned* bar, volatile LAS unsigned* st) {
    XcdBarrier b; b.bar = bar; b.x = xb_xcc_id(); b.st = st;
    if (threadIdx.x == 0) (void)xb_add(&bar[XB_XCNT(b.x)], 1u);
    return b;
}
__device__ __forceinline__ void xcd_barrier_complete(unsigned* bar, unsigned x, unsigned& nloc, unsigned& nx) {
    const unsigned G = gridDim.x * gridDim.y * gridDim.z;
    unsigned sum, cnt, mine, sp = 0u;
    for (;;) {
        sum = 0u; cnt = 0u; mine = 0u;
#pragma unroll
        for (unsigned j = 0; j < 16; ++j) { const unsigned c = xb_ld(&bar[XB_XCNT(j)]); sum += c; cnt += (c > 0u) ? 1u : 0u; mine = (j == x) ? c : mine; }
        if (sum == G) break;
        __builtin_amdgcn_s_sleep(1);
        if ((++sp & 255u) == 0u) { if (xb_ld(&bar[XB_TMO])) break; if (sp > XB_SPIN_CAP) { atomicAdd(&bar[XB_TMO], 1u); break; } }
    }
    nloc = mine > 0u ? mine : 1u; nx = cnt > 0u ? cnt : 1u;
}

__device__ __forceinline__ void xcd_barrier(const XcdBarrier& b) {
    asm volatile("s_waitcnt vmcnt(0)" ::: "memory");
    __syncthreads();
    if (threadIdx.x == 0) {
        unsigned* bar = b.bar;
        __builtin_amdgcn_s_waitcnt(0);
        unsigned nloc = b.st[0], nx = b.st[1];
        if (nloc == 0u) { xcd_barrier_complete(bar, b.x, nloc, nx); b.st[0] = nloc; b.st[1] = nx; }
        const unsigned old = xb_add(&bar[XB_XSUB(b.x)], 1u);
        const unsigned gen = old / nloc;
        if (old + 1u == (gen + 1u) * nloc) {
            __builtin_amdgcn_fence(__ATOMIC_RELEASE, "agent");
            asm volatile("s_waitcnt vmcnt(0)" ::: "memory");
            const unsigned og = xb_add(&bar[XB_TOP], 1u);
            const unsigned tg = og / nx;
            if (og + 1u == (tg + 1u) * nx) xb_add(&bar[XB_TOPGEN], 1u);
            else XB_SPIN(xb_ld(&bar[XB_TOPGEN]) == tg, bar);
            __builtin_amdgcn_fence(__ATOMIC_ACQUIRE, "agent");
            xb_add(&bar[XB_XGEN(b.x)], 1u);
            asm volatile("s_waitcnt vmcnt(0)" ::: "memory");
        } else {
            XB_SPIN(xb_ld(&bar[XB_XGEN(b.x)]) == gen, bar);
            __builtin_amdgcn_fence(__ATOMIC_ACQUIRE, "agent");
            asm volatile("s_waitcnt vmcnt(0)" ::: "memory");
        }
    }
    __syncthreads();
}

__device__ __forceinline__ void p0_transpose_item64(const float* __restrict__ W, int N, bf16_t* __restrict__ WT, int K, int k0, int n0src, int n0dst, LAS float* scr, int lane) {
    const int kr = lane >> 4, cq = lane & 15;
    f32x4 v[16];
#pragma unroll
    for (int i = 0; i < 16; ++i) v[i] = *(const f32x4*)(W + (size_t)(k0 + 4 * i + kr) * N + n0src + 4 * cq);
#pragma unroll
    for (int i = 0; i < 16; ++i) { LAS float* p = scr + (4 * i + kr) * 65 + 4 * cq; p[0] = v[i][0]; p[1] = v[i][1]; p[2] = v[i][2]; p[3] = v[i][3]; }
    LDS_WAIT();
    const int c = lane & 7, nn = lane >> 3;
#pragma unroll
    for (int jj = 0; jj < 8; ++jj) { const int n = nn + 8 * jj; const LAS float* s = scr + (8 * c) * 65 + n;
        u32x4 o; o.x = pk2(s[0], s[65]); o.y = pk2(s[2 * 65], s[3 * 65]); o.z = pk2(s[4 * 65], s[5 * 65]); o.w = pk2(s[6 * 65], s[7 * 65]);
        *(u32x4*)(WT + (size_t)(n0dst + n) * K + k0 + 8 * c) = o; }
    LDS_WAIT();
}

constexpr int TI_1 = 32 * 96, TI_2 = 32 * 32, TI_3 = 32 * 128, TI_4 = 128 * 32, TI_ALL = TI_1 + TI_2 + TI_3 + TI_4;
struct TItem { const float* W; bf16_t* WT; int N, K, k0, ns, nd, f8; };
__device__ __forceinline__ TItem titem_decode(const Args& a, int r) {
    TItem t;
    if (r < TI_1) { const int kb = r / 96, nb = r % 96, nd = 64 * nb; const bool oz = nd >= 2048 && nd < 4096;
        t.f8 = oz ? 1 : 0; t.W = a.in[I_WIN]; t.WT = oz ? (bf16_t*)(a.ws + WS_WIN8) : (bf16_t*)(a.ws + WS_WIN); t.N = WIN_N; t.K = DM; t.k0 = 64 * kb; t.ns = nd + (nd >= 3072 ? 16 : 0); t.nd = oz ? nd - 2048 : nd; return t; } r -= TI_1;
    if (r < TI_2) { const int kb = r / 32, nb = r % 32; t.f8 = 1; t.W = a.in[I_WOUT]; t.WT = (bf16_t*)(a.ws + WS_WOUT); t.N = DM; t.K = DM; t.k0 = 64 * kb; t.ns = 64 * nb; t.nd = 64 * nb; return t; } r -= TI_2;
    if (r < TI_3) { const int kb = r / 128, nb = r % 128; t.f8 = 1; t.W = a.in[I_WMI]; t.WT = (bf16_t*)(a.ws + WS_WMI); t.N = DFF; t.K = DM; t.k0 = 64 * kb; t.ns = 64 * nb; t.nd = 64 * nb; return t; } r -= TI_3;
    { const int kb = r / 32, nb = r % 32; t.f8 = 1; t.W = a.in[I_WMO]; t.WT = (bf16_t*)(a.ws + WS_WMO); t.N = DM; t.K = DFF; t.k0 = 64 * kb; t.ns = 64 * nb; t.nd = 64 * nb; return t; }
}
__device__ __forceinline__ void titem_load(const TItem& t, int lane, f32x4 (&v)[16]) {
    const int kr = lane >> 4, cq = lane & 15;
#pragma unroll
    for (int i = 0; i < 16; ++i) v[i] = *(const f32x4*)(t.W + (size_t)(t.k0 + 4 * i + kr) * t.N + t.ns + 4 * cq);
}
__device__ __forceinline__ void titem_store(const TItem& t, int lane, const f32x4 (&v)[16], LAS float* scr) {
    const int kr = lane >> 4, cq = lane & 15;
#pragma unroll
    for (int i = 0; i < 16; ++i) { LAS float* p = scr + (4 * i + kr) * 65 + 4 * cq; p[0] = v[i][0]; p[1] = v[i][1]; p[2] = v[i][2]; p[3] = v[i][3]; }
    LDS_WAIT();
    const int c = lane & 7, nn = lane >> 3;
#pragma unroll
    for (int jj = 0; jj < 8; ++jj) { const int n = nn + 8 * jj; const LAS float* q = scr + (8 * c) * 65 + n;
        if (t.f8) { int p0 = __builtin_amdgcn_cvt_pk_fp8_f32(128.f * q[0], 128.f * q[65], 0, false); p0 = __builtin_amdgcn_cvt_pk_fp8_f32(128.f * q[2 * 65], 128.f * q[3 * 65], p0, true);
            int p1 = __builtin_amdgcn_cvt_pk_fp8_f32(128.f * q[4 * 65], 128.f * q[5 * 65], 0, false); p1 = __builtin_amdgcn_cvt_pk_fp8_f32(128.f * q[6 * 65], 128.f * q[7 * 65], p1, true);
            *(u32x2*)((unsigned char*)t.WT + (size_t)(t.nd + n) * t.K + t.k0 + 8 * c) = (u32x2){(unsigned)p0, (unsigned)p1}; }
        else { u32x4 o; o.x = pk2(q[0], q[65]); o.y = pk2(q[2 * 65], q[3 * 65]); o.z = pk2(q[4 * 65], q[5 * 65]); o.w = pk2(q[6 * 65], q[7 * 65]);
            *(u32x4*)(t.WT + (size_t)(t.nd + n) * t.K + t.k0 + 8 * c) = o; } }
    LDS_WAIT();
}
__device__ __forceinline__ void transpose_items(const Args& a, lds8* lds, int lane, int wave, int gw, int NGW, int it_lo, int it_hi) {
    LAS float* scr = (LAS float*)(lds + wave * 16640);
    int it = it_lo + gw; if (it >= it_hi) return;
    f32x4 va[16], vb[16]; TItem ia = titem_decode(a, it), ib = ia;
    titem_load(ia, lane, va);
    for (;;) {
        const int itb = it + NGW; const bool hb = itb < it_hi;
        if (hb) { ib = titem_decode(a, itb); titem_load(ib, lane, vb); }
        titem_store(ia, lane, va, scr);
        if (!hb) break;
        const int ita = itb + NGW; const bool ha = ita < it_hi;
        if (ha) { ia = titem_decode(a, ita); titem_load(ia, lane, va); }
        titem_store(ib, lane, vb, scr);
        if (!ha) break;
        it = ita;
    }
}
__device__ __forceinline__ void p0_phase(const Args& a, lds8* lds, int tid, int lane, int wave, int blk, int nblk) {
    {
        LAS float* sc = (LAS float*)lds;
        LAS float* red = sc + 3 * DM;
        for (int i = tid; i < 3 * DM; i += NTHR) { const int c = i >> 11, k = i & (DM - 1); const float v = (c == 0) ? a.in[I_CCTX][k] : a.in[I_C][(c - 1) * DM + k]; sc[i] = siluf(v); }
        __syncthreads();
        const float* wm = a.in[I_WMOD]; float* MOD = (float*)(a.ws + WS_MOD);
        for (int slab = blk; slab < 256; slab += nblk) {
            const int col0 = slab * 48, cq = tid % 12, rg = tid / 12;
            float acc[3][4];
#pragma unroll
            for (int c = 0; c < 3; ++c)
#pragma unroll
                for (int j = 0; j < 4; ++j) acc[c][j] = 0.f;
            if (rg < 42) {
#pragma unroll 7
                for (int k = rg; k < DM; k += 42) { const f32x4 w = *(const f32x4*)(wm + (size_t)k * 12288 + col0 + 4 * cq); const float s0 = sc[k], s1 = sc[DM + k], s2 = sc[2 * DM + k];
#pragma unroll
                    for (int j = 0; j < 4; ++j) { acc[0][j] += s0 * w[j]; acc[1][j] += s1 * w[j]; acc[2][j] += s2 * w[j]; } }
#pragma unroll
                for (int c = 0; c < 3; ++c)
#pragma unroll
                    for (int j = 0; j < 4; ++j) red[(rg * 12 + cq) * 12 + c * 4 + j] = acc[c][j];
            }
            __syncthreads();
            if (tid < 144) { const int c = tid / 48, col = tid % 48; float s = 0.f;
                for (int r = 0; r < 42; ++r) s += red[(r * 12 + (col >> 2)) * 12 + c * 4 + (col & 3)];
                MOD[c * 12288 + col0 + col] = s + a.in[I_BMOD][col0 + col]; }
            __syncthreads();
        }
    }
    {
        bf16_t* WG = (bf16_t*)(a.ws + WS_WG); const float* W = a.in[I_WIN];
        for (int i = blk * NTHR + tid; i < NGATE * DM; i += nblk * NTHR) { const int n = i >> 11, k = i & (DM - 1); const int src = n < 16 ? 3072 + n : 6160 + (n - 16);
            WG[i] = (bf16_t)(pk2(W[(size_t)k * WIN_N + src], 0.f) & 0xffffu); }
    }
    transpose_items(a, lds, lane, wave, blk * 8 + wave, nblk * 8, 0, nblk == 256 ? TI_1 : TI_ALL);
}

__device__ __forceinline__ void p1_phase(const Args& a, lds8* lds, int tid, int lane, int wave, int blk, int nblk) {
    constexpr int URS = 4112;
    bf16_t* U = (bf16_t*)(a.ws + WS_U); const float* MOD = (const float*)(a.ws + WS_MOD); const bf16_t* WG = (const bf16_t*)(a.ws + WS_WG); float* G = (float*)(a.ws + WS_G);
    for (int c = blk; c < 3; c += nblk) { float* mc = (float*)(a.ws + WS_MODC) + c * 3 * DM; const float* md = MOD + c * 12288;
        for (int col = tid; col < DM; col += NTHR) { mc[col] = md[4096 + col] * a.in[I_GPOSTMIX][col]; mc[DM + col] = a.in[I_GPREMLP][col] * (1.f + md[8192 + col]); mc[2 * DM + col] = md[10240 + col] * a.in[I_GPOSTMLP][col]; } }
    for (int rg = blk; rg < NTOK / 32; rg += nblk) {
        for (int rr = 0; rr < 4; ++rr) {
            const int r = 4 * wave + rr, row = 32 * rg + r;
            const f32x4* xr = (const f32x4*)xrow_ptr(a, row) + lane; const float* md = MOD + cond_of(row) * 12288;
            f32x4 v[8], gv[8], sv[8], hv[8];
#pragma unroll
            for (int j = 0; j < 8; ++j) { const int col = 4 * lane + 256 * j; v[j] = xr[64 * j]; gv[j] = *(const f32x4*)(a.in[I_GPREMIX] + col); sv[j] = *(const f32x4*)(md + 2048 + col); hv[j] = *(const f32x4*)(md + col); }
            SBAR0();
            float ss = 0.f;
#pragma unroll
            for (int j = 0; j < 8; ++j) ss += (v[j][0] * v[j][0] + v[j][1] * v[j][1]) + (v[j][2] * v[j][2] + v[j][3] * v[j][3]);
            const float rstd = rsqrtf(wave_sum(ss) * (1.f / DM) + EPS);
#pragma unroll
            for (int j = 0; j < 8; ++j) { const int col = 4 * lane + 256 * j;
                const f32x4 o = v[j] * rstd * gv[j] * (1.f + sv[j]) + hv[j];
                u32x2 w; w.x = pk2(o[0], o[1]); w.y = pk2(o[2], o[3]);
                *(u32x2*)(U + (size_t)row * DM + col) = w; *(LAS u32x2*)(lds + r * URS + col * 2) = w;
                { int p = __builtin_amdgcn_cvt_pk_fp8_f32(o[0], o[1], 0, false); p = __builtin_amdgcn_cvt_pk_fp8_f32(o[2], o[3], p, true); *(int*)(a.ws + WS_U8 + (size_t)row * DM + col) = p; } }
        }
        __syncthreads();
        f32x4 acc[2][3];
#pragma unroll
        for (int mi = 0; mi < 2; ++mi)
#pragma unroll
            for (int ni = 0; ni < 3; ++ni) acc[mi][ni] = (f32x4){0.f, 0.f, 0.f, 0.f};
#pragma unroll 2
        for (int kk = 0; kk < 8; ++kk) { const int kb = 256 * wave + 32 * kk + 8 * (lane >> 4);
            bf16x8 av[2], bv[3];
#pragma unroll
            for (int mi = 0; mi < 2; ++mi) av[mi] = *(const LAS bf16x8*)(lds + (16 * mi + (lane & 15)) * URS + kb * 2);
#pragma unroll
            for (int ni = 0; ni < 3; ++ni) bv[ni] = *(const bf16x8*)(WG + (size_t)(16 * ni + (lane & 15)) * DM + kb);
#pragma unroll
            for (int mi = 0; mi < 2; ++mi)
#pragma unroll
                for (int ni = 0; ni < 3; ++ni) acc[mi][ni] = __builtin_amdgcn_mfma_f32_16x16x32_bf16(av[mi], bv[ni], acc[mi][ni], 0, 0, 0); }
        __syncthreads();
        LAS float* part = (LAS float*)lds;
#pragma unroll
        for (int mi = 0; mi < 2; ++mi)
#pragma unroll
            for (int ni = 0; ni < 3; ++ni)
#pragma unroll
                for (int r = 0; r < 4; ++r) part[wave * 1536 + (16 * mi + 4 * (lane >> 4) + r) * 48 + 16 * ni + (lane & 15)] = acc[mi][ni][r];
        __syncthreads();
        for (int i = tid; i < 1536; i += NTHR) { float s = 0.f;
#pragma unroll
            for (int w = 0; w < 8; ++w) s += part[w * 1536 + i];
            const int rrow = i / 48, n = i % 48; float val;
            if (n < 8) val = s + a.in[I_BIG][n];
            else if (n < 16) { const float x = s + a.in[I_BFG][n - 8]; val = fminf(x, 0.f) - log1pf(expf(-fabsf(x))); }
            else { const float x = s + a.in[I_DTB][n - 16]; val = fmaxf(x, 0.f) + log1pf(expf(-fabsf(x))); }
            G[(size_t)(32 * rg + rrow) * NGATE + n] = val; }
        __syncthreads();
    }
}

__device__ __forceinline__ void p3_phase(const Args& a, int tid, int blk, int nblk) {
    const bf16_t* P = (const bf16_t*)(a.ws + WS_P) + 4096; bf16_t* XC = (bf16_t*)(a.ws + WS_XC);
    const int gt = blk * NTHR + tid, total = nblk * NTHR, ch = gt & 255;
    float w[9][8], bias[8];
#pragma unroll
    for (int t = 0; t < 9; ++t)
#pragma unroll
        for (int e = 0; e < 8; ++e) w[t][e] = a.in[I_CONVW][t * 2048 + 8 * ch + e];
#pragma unroll
    for (int e = 0; e < 8; ++e) bias[e] = a.in[I_CONVB][8 * ch + e];
    for (int tok = gt >> 8; tok < NTOK; tok += total >> 8) {
        float acc[8];
#pragma unroll
        for (int e = 0; e < 8; ++e) acc[e] = bias[e];
        const bool pr = tok < NPR; const int lt = pr ? (tok & 255) : ((tok - NPR) & 2047);
        const int gy = pr ? 0 : (lt >> 6), gx = pr ? lt : (lt & 63), H = pr ? 1 : 32, Wd = pr ? 256 : 64;
        const bf16_t* pc = P + 8 * ch;
        if (pr) {
            u32x4 v[3]; float f[3];
#pragma unroll
            for (int j = 0; j < 3; ++j) { const int xx = gx + j - 1; const bool ok = xx >= 0 && xx < Wd; f[j] = ok ? 1.f : 0.f; v[j] = *(const u32x4*)(pc + (size_t)(ok ? tok + j - 1 : tok) * NPJ); }
#pragma unroll
            for (int j = 0; j < 3; ++j)
#pragma unroll
                for (int q = 0; q < 4; ++q) { acc[2 * q] += (w[3 + j][2 * q] * f[j]) * bflo(v[j][q]); acc[2 * q + 1] += (w[3 + j][2 * q + 1] * f[j]) * bfhi(v[j][q]); }
        } else {
            u32x4 v[9]; float f[9];
#pragma unroll
            for (int i = 0; i < 3; ++i)
#pragma unroll
                for (int j = 0; j < 3; ++j) { const int yy = gy + i - 1, xx = gx + j - 1; const bool ok = yy >= 0 && yy < H && xx >= 0 && xx < Wd; f[i * 3 + j] = ok ? 1.f : 0.f;
                    v[i * 3 + j] = *(const u32x4*)(pc + (size_t)(ok ? tok + (i - 1) * 64 + (j - 1) : tok) * NPJ); }
#pragma unroll
            for (int t = 0; t < 9; ++t)
#pragma unroll
                for (int q = 0; q < 4; ++q) { acc[2 * q] += (w[t][2 * q] * f[t]) * bflo(v[t][q]); acc[2 * q + 1] += (w[t][2 * q + 1] * f[t]) * bfhi(v[t][q]); }
        }
        u32x4 o;
#pragma unroll
        for (int q = 0; q < 4; ++q) o[q] = pk2(siluf(acc[2 * q]), siluf(acc[2 * q + 1]));
        *(u32x4*)(XC + (size_t)tok * DM + 8 * ch) = o;
    }
    {
        const float* G = (const float*)(a.ws + WS_G); float* PRE = (float*)(a.ws + WS_PRE);
        const int lane = tid & 63, gw = blk * 8 + (tid >> 6), NGW = nblk * 8;
        for (int task = gw; task < 2560; task += NGW) {
            const bool ml = task < 512; const int t = ml ? task : task - 512, half = ml ? 256 : 1024;
            const bool smp = t >= half; const int seq = smp ? (t - half) >> 4 : t >> 1, c = smp ? (t - half) & 15 : t & 1, nc = smp ? 16 : 2;
            const int hs = ml ? 4 : 16, hd = seq % hs, dir = (seq / hs) & 1, b = seq / (2 * hs);
            const int tok0 = smp ? NPR + b * 2048 : b * 256, blkc = dir ? nc - 1 - c : c, tb = tok0 + blkc * 128;
            const int r0 = 2 * lane, r1 = 2 * lane + 1; const size_t t0 = (size_t)(tb + (dir ? 127 - r0 : r0)) * NGATE, t1 = (size_t)(tb + (dir ? 127 - r1 : r1)) * NGATE;
            float x0, x1, i0 = 0.f, i1 = 0.f;
            if (ml) { i0 = G[t0 + dir * 4 + hd]; i1 = G[t1 + dir * 4 + hd]; x0 = G[t0 + 8 + dir * 4 + hd]; x1 = G[t1 + 8 + dir * 4 + hd]; }
            else { const float aneg = -expf(a.in[I_ALOG][dir * 16 + hd]); i0 = G[t0 + 16 + dir * 16 + hd]; i1 = G[t1 + 16 + dir * 16 + hd]; x0 = i0 * aneg; x1 = i1 * aneg; }
            const float p1 = x0 + x1; float v = p1;
#pragma unroll
            for (int o = 1; o < 64; o <<= 1) { const float tt = __shfl_up(v, o); if (lane >= o) v += tt; }
            const float ex = v - p1, b0 = ex + x0, b1 = ex + p1;
            if (ml) { const float a0 = i0 - b0, a1 = i1 - b1; float w = fmaxf(a0, a1);
#pragma unroll
                for (int o = 1; o < 64; o <<= 1) { const float tt = __shfl_up(w, o); if (lane >= o) w = fmaxf(w, tt); }
                float wp = __shfl_up(w, 1); if (lane == 0) wp = -INFINITY;
                float* p = PRE + (size_t)task * 384;
                *(f32x2_t*)(p + r0) = (f32x2_t){a0, a1}; *(f32x2_t*)(p + 128 + r0) = (f32x2_t){b0, b1}; *(f32x2_t*)(p + 256 + r0) = (f32x2_t){fmaxf(wp, a0), w};
            } else { float* p = PRE + PRE_SSD_OFF + (size_t)t * 256;
                *(f32x2_t*)(p + r0) = (f32x2_t){b0, b1}; *(f32x2_t*)(p + 128 + r0) = (f32x2_t){i0, i1}; }
        }
    }
}

constexpr int RS = 288;
constexpr int RSV = 160;
constexpr int L_Q = 0, L_K = 128 * RS, L_S = 2 * 128 * RS, L_V = 3 * 128 * RS, L_ST = L_V + 128 * RSV, L_VEC = L_ST + 80 * RS;
static_assert(L_VEC + 8 * 128 * 4 <= LDS_BYTES - 64, "scan LDS map");
#define MFMA16(a, b, c) __builtin_amdgcn_mfma_f32_16x16x32_bf16(a, b, c, 0, 0, 0)

template <bool ML>
__device__ __forceinline__ void scan_unit(const Args& a, lds8* lds, const bool sample, const int u, const int tid, const int lane, const int wave) {
    constexpr int EB = ML ? 5 : 4;
    const int sl = ML ? (u & 3) : 0, hd = ML ? ((u >> 2) & 3) : (u & 15), dir = (u >> 4) & 1, b = u >> 5;
    const int tok0 = sample ? NPR + b * 2048 : b * 256, nc = sample ? 16 : 2;
    const bf16_t* Pw = (const bf16_t*)(a.ws + WS_P); const bf16_t* XC = (const bf16_t*)(a.ws + WS_XC);
    const bf16_t *srcQ, *srcK, *srcV; int pitch; bf16_t* outp;
    if (ML) { srcQ = Pw + hd * 128; srcK = Pw + 512 + hd * 128; srcV = Pw + 1024 + hd * 256 + sl * 64; pitch = NPJ;
              outp = (bf16_t*)(a.ws + WS_HY) + (size_t)dir * HY_STRIDE + hd * 256 + sl * 64; }
    else { const int g = hd >> 2; srcQ = XC + 1536 + g * 128; srcK = XC + 1024 + g * 128; srcV = XC + hd * 64; pitch = DM;
           outp = (bf16_t*)(a.ws + WS_HY) + (size_t)(2 + dir) * HY_STRIDE + hd * 64; }
    LAS float* VEC = (LAS float*)(lds + L_VEC);
    LAS float *RA = VEC, *CA = VEC + 128, *CM = VEC + 256, *IS = VEC + 384, *WK = VEC + 512, *DN = VEC + 640, *SC = VEC + 768;
    const int fr = lane & 15, fq = lane >> 4;
    const float qs = 0.08838834764831845f;

    f32x4 st[EB]; float m = 0.f;
#pragma unroll
    for (int eb = 0; eb < EB; ++eb) st[eb] = (f32x4){0.f, 0.f, 0.f, 0.f};
    if (sample) {
        const int sidx = (b * 2 + dir) * (ML ? 4 : 16) + hd;
        if (ML) { const float* cb = a.in[I_SC] + (size_t)sidx * 32768;
#pragma unroll
            for (int eb = 0; eb < 4; ++eb)
#pragma unroll
                for (int r = 0; r < 4; ++r) st[eb][r] = cb[(16 * wave + 4 * fq + r) * 256 + sl * 64 + 16 * eb + fr];
            if (fr == 0) {
#pragma unroll
                for (int r = 0; r < 4; ++r) st[EB - 1][r] = a.in[I_SN][sidx * 128 + 16 * wave + 4 * fq + r]; }
            m = a.in[I_SM][sidx];
        } else { const float* sb = a.in[I_SS] + (size_t)sidx * 8192;
#pragma unroll
            for (int eb = 0; eb < 4; ++eb) st[eb] = *(const f32x4*)(sb + (16 * eb + fr) * 128 + 16 * wave + 4 * fq); }
    }
    __syncthreads();
#pragma unroll
    for (int eb = 0; eb < EB; ++eb) { u32x2 w; w.x = pk2(st[eb][0], st[eb][1]); w.y = pk2(st[eb][2], st[eb][3]);
        *(LAS u32x2*)(lds + L_ST + (16 * eb + fr) * RS + (16 * wave + 4 * fq) * 2) = w; }
    if (tid < 256) { const int row = tid >> 1, hf = tid & 1;
        *(LAS u32x4*)(lds + L_V + row * RSV + 128 + 16 * hf) = (u32x4){(ML && hf == 0) ? 0x00003f80u : 0u, 0u, 0u, 0u}; }

    u32x4 rq[4], rk[4], rv[2]; float pv[5];
#define TROW(r) (dir ? 127 - (r) : (r))
    unsigned oq[4], ov[2];
#pragma unroll
    for (int i = 0; i < 4; ++i) { const int it = tid + NTHR * i, r = it >> 4, chn = it & 15; oq[i] = (unsigned)(TROW(r) * pitch + 8 * chn) * 2u; }
#pragma unroll
    for (int i = 0; i < 2; ++i) { const int it = tid + NTHR * i, r = it >> 3, chn = it & 7; ov[i] = (unsigned)(TROW(r) * pitch + 8 * chn) * 2u; }
    const int pseq = (b * 2 + dir) * (ML ? 4 : 16) + hd;
    const float* pre0 = (const float*)(a.ws + WS_PRE) + (ML ? (size_t)(sample ? 256 + pseq * 16 : pseq * 2) * 384 : PRE_SSD_OFF + (size_t)(sample ? 1024 + pseq * 16 : pseq * 2) * 256);
#define ISSUE_LOADS(c) do { const int _blkc = dir ? nc - 1 - (c) : (c); const size_t _tb = (size_t)(tok0 + _blkc * 128); \
        const char* _bq = (const char*)(srcQ + _tb * pitch); const char* _bk = (const char*)(srcK + _tb * pitch); const char* _bv = (const char*)(srcV + _tb * pitch); \
        _Pragma("unroll") for (int _i = 0; _i < 4; ++_i) { rq[_i] = *(const u32x4*)(_bq + oq[_i]); rk[_i] = *(const u32x4*)(_bk + oq[_i]); } \
        rv[0] = *(const u32x4*)(_bv + ov[0]); rv[1] = *(const u32x4*)(_bv + ov[1]); \
        if (tid < 128) { const float* _p = pre0 + (size_t)(c) * (ML ? 384 : 256); pv[0] = _p[tid]; pv[1] = _p[128 + tid]; pv[2] = ML ? _p[256 + tid] : _p[127]; pv[3] = ML ? _p[256 + 127] : 0.f; pv[4] = ML ? _p[128 + 127] : 0.f; } \
    } while (0)
    ISSUE_LOADS(0);

#pragma unroll 1
    for (int c = 0; c < nc; ++c) {
        const int blkc = dir ? nc - 1 - c : c; const int tb = tok0 + blkc * 128;
        int tidv = tid, frv = fr, fqv = fq; asm volatile("" : "+v"(tidv), "+v"(frv), "+v"(fqv));
#pragma unroll
        for (int i = 0; i < 4; ++i) { const int it = tidv + NTHR * i, r = it >> 4, chn = it & 15; *(LAS u32x4*)(lds + L_Q + r * RS + 16 * chn) = rq[i]; *(LAS u32x4*)(lds + L_K + r * RS + 16 * chn) = rk[i]; }
#pragma unroll
        for (int i = 0; i < 2; ++i) { const int it = tidv + NTHR * i, r = it >> 3, chn = it & 7; *(LAS u32x4*)(lds + L_V + r * RSV + 16 * chn) = rv[i]; }
        if (tidv < 128) {
            if (ML) { const float av = pv[0], bv = pv[1], M = fmaxf(m, pv[2]), Ml = fmaxf(m, pv[3]);
                RA[tidv] = -M; CA[tidv] = av; CM[tidv] = qs; IS[tidv] = qs * __expf(m - M); WK[tidv] = __expf(av - Ml); DN[tidv] = __expf(-(bv + M));
                if (tidv == 0) { SC[0] = __expf(m - Ml); SC[1] = pv[4] + Ml; }
            } else { const float cs = pv[0], dtv = pv[1], tot = pv[2];
                RA[tidv] = cs; CA[tidv] = -cs; CM[tidv] = dtv; IS[tidv] = __expf(cs); WK[tidv] = __expf(tot - cs) * dtv;
                if (tidv == 0) { SC[0] = __expf(tot); SC[1] = 0.f; } }
        }
        if (c + 1 < nc) ISSUE_LOADS(c + 1);
        __syncthreads();
        const float decay = SC[0], m_next = SC[1];
        const int t_w = 16 * wave + frv;
#define SB() __builtin_amdgcn_sched_barrier(0)
#define LDF(off) (*(const LAS bf16x8*)(lds + (off)))
#define KO(kk) ((32 * (kk) + 8 * fqv) * 2)
        f32x4 ah[EB];
#pragma unroll
        for (int eb = 0; eb < EB; ++eb) ah[eb] = (f32x4){0.f, 0.f, 0.f, 0.f};
        f32x4 as[2][4];
        const int sb0 = 2 * (wave >> 1), tb0 = 4 * (wave & 1);
#pragma unroll
        for (int i = 0; i < 2; ++i)
#pragma unroll
            for (int j = 0; j < 4; ++j) as[i][j] = (f32x4){0.f, 0.f, 0.f, 0.f};
        bf16x8 fb[2], fa[2][EB];
        bf16x8 gk[2][2], gq[2][4];
        const int oq_t = L_Q + t_w * RS, ost = L_ST + frv * RS, ok1 = L_K + (16 * sb0 + frv) * RS, oq1 = L_Q + (16 * tb0 + frv) * RS;
#define L3(bf, kk) do { fb[bf] = LDF(oq_t + KO(kk)); _Pragma("unroll") for (int eb = 0; eb < EB; ++eb) fa[bf][eb] = LDF(ost + 16 * eb * RS + KO(kk)); } while (0)
#define M3(bf) do { _Pragma("unroll") for (int eb = 0; eb < EB; ++eb) ah[eb] = MFMA16(fa[bf][eb], fb[bf], ah[eb]); } while (0)
#define L1(bf, kk) do { _Pragma("unroll") for (int i = 0; i < 2; ++i) gk[bf][i] = LDF(ok1 + 16 * i * RS + KO(kk)); _Pragma("unroll") for (int j = 0; j < 4; ++j) gq[bf][j] = LDF(oq1 + 16 * j * RS + KO(kk)); } while (0)
#define M1(bf) do { _Pragma("unroll") for (int i = 0; i < 2; ++i) _Pragma("unroll") for (int j = 0; j < 4; ++j) as[i][j] = MFMA16(gk[bf][i], gq[bf][j], as[i][j]); } while (0)
        const float isv = IS[t_w];
        L3(0, 0); SB();
        L3(1, 1); SB(); M3(0); SB();
        L3(0, 2); SB(); M3(1); SB();
        L3(1, 3); SB(); M3(0); SB();
        L1(0, 0); SB(); M3(1); SB();
#pragma unroll
        for (int eb = 0; eb < EB; ++eb) ah[eb] *= isv;
        L1(1, 1); SB(); M1(0); SB();
        L1(0, 2); SB(); M1(1); SB();
        L1(1, 3); SB(); M1(0); SB();
        f32x4 ca[2], cm[2]; float rav[4];
#pragma unroll
        for (int i = 0; i < 2; ++i) { const int s0 = 16 * (sb0 + i) + 4 * fqv; ca[i] = *(const LAS f32x4*)(CA + s0); cm[i] = *(const LAS f32x4*)(CM + s0); }
#pragma unroll
        for (int j = 0; j < 4; ++j) rav[j] = RA[16 * (tb0 + j) + frv];
        SB(); M1(1); SB();
#pragma unroll
        for (int i = 0; i < 2; ++i) { const int s0 = 16 * (sb0 + i) + 4 * fqv;
#pragma unroll
            for (int j = 0; j < 4; ++j) { const int t = 16 * (tb0 + j) + frv; float val[4];
#pragma unroll
                for (int r = 0; r < 4; ++r) { const float wgt = (s0 + r <= t) ? __expf(rav[j] + ca[i][r]) * cm[i][r] : 0.f; val[r] = as[i][j][r] * wgt; }
                u32x2 w; w.x = pk2(val[0], val[1]); w.y = pk2(val[2], val[3]);
                *(LAS u32x2*)(lds + L_S + t * RS + s0 * 2) = w; } }
        __syncthreads();
        typedef short v4i16_t __attribute__((ext_vector_type(4)));
#define TRF(off) __builtin_shufflevector(__builtin_amdgcn_ds_read_tr16_b64_v4i16((LAS v4i16_t*)(lds + (off))), __builtin_amdgcn_ds_read_tr16_b64_v4i16((LAS v4i16_t*)(lds + (off) + 4 * TRS)), 0, 1, 2, 3, 4, 5, 6, 7)
        const int trq = (8 * fqv + (frv >> 2)), trp = 8 * (frv & 3);
        const int os_t = L_S + t_w * RS, ovt = L_V + trq * RSV + trp, okt = L_K + trq * RS + trp + 32 * wave;
        u32x4 hk[2]; f32x4 hw[2][2];
#define L2(bf, kk) do { fb[bf] = LDF(os_t + KO(kk)); { constexpr int TRS = RSV; _Pragma("unroll") for (int eb = 0; eb < EB; ++eb) fa[bf][eb] = TRF(ovt + 32 * (kk) * RSV + 32 * eb); } } while (0)
#define L4(bf, kk) do { { constexpr int TRS = RS; hk[bf] = __builtin_bit_cast(u32x4, TRF(okt + 32 * (kk) * RS)); } hw[bf][0] = *(const LAS f32x4*)(WK + 32 * (kk) + 8 * fqv); hw[bf][1] = *(const LAS f32x4*)(WK + 32 * (kk) + 8 * fqv + 4); \
            { constexpr int TRS = RSV; _Pragma("unroll") for (int eb = 0; eb < EB; ++eb) fa[bf][eb] = TRF(ovt + 32 * (kk) * RSV + 32 * eb); } } while (0)
#define M4(bf) do { u32x4 ks; ks.x = pk2(bflo(hk[bf].x) * hw[bf][0][0], bfhi(hk[bf].x) * hw[bf][0][1]); ks.y = pk2(bflo(hk[bf].y) * hw[bf][0][2], bfhi(hk[bf].y) * hw[bf][0][3]); \
            ks.z = pk2(bflo(hk[bf].z) * hw[bf][1][0], bfhi(hk[bf].z) * hw[bf][1][1]); ks.w = pk2(bflo(hk[bf].w) * hw[bf][1][2], bfhi(hk[bf].w) * hw[bf][1][3]); \
            const bf16x8 av = __builtin_bit_cast(bf16x8, ks); _Pragma("unroll") for (int eb = 0; eb < EB; ++eb) st[eb] = MFMA16(av, fa[bf][eb], st[eb]); } while (0)
        L2(0, 0); SB();
#pragma unroll
        for (int eb = 0; eb < EB; ++eb) st[eb] *= decay;
        L2(1, 1); SB(); M3(0); SB();
        L2(0, 2); SB(); M3(1); SB();
        L2(1, 3); SB(); M3(0); SB();
        L4(0, 0); SB(); M3(1); SB();
        L4(1, 1); SB(); M4(0); SB();
        { float inv = 1.f;
          if (ML) { const float den = __shfl(ah[EB - 1][0], frv); inv = 1.f / fmaxf(fabsf(den), DN[t_w]); }
          bf16_t* op = outp + (size_t)(tb + TROW(t_w)) * 1024 + 4 * fqv;
#pragma unroll
          for (int eb = 0; eb < 4; ++eb) { u32x2 w; w.x = pk2(ah[eb][0] * inv, ah[eb][1] * inv); w.y = pk2(ah[eb][2] * inv, ah[eb][3] * inv); *(u32x2*)(op + 16 * eb) = w; } }
        L4(0, 2); SB(); M4(1); SB();
        L4(1, 3); SB(); M4(0); SB();
        M4(1);
#pragma unroll
        for (int eb = 0; eb < EB; ++eb) { u32x2 w; w.x = pk2(st[eb][0], st[eb][1]); w.y = pk2(st[eb][2], st[eb][3]);
            *(LAS u32x2*)(lds + L_ST + (16 * eb + frv) * RS + (16 * wave + 4 * fqv) * 2) = w; }
#undef L1
#undef L2
#undef L3
#undef L4
#undef M1
#undef M3
#undef M4
#undef TRF
#undef SB
#undef LDF
#undef KO
        m = m_next;
        __syncthreads();
    }
    if (!sample) {
        float* out = a.out;
        if (ML) { const int sidx = (b * 2 + dir) * 4 + hd;
#pragma unroll
            for (int eb = 0; eb < 4; ++eb)
#pragma unroll
                for (int r = 0; r < 4; ++r) out[O_C + (size_t)sidx * 32768 + (16 * wave + 4 * fq + r) * 256 + sl * 64 + 16 * eb + fr] = st[eb][r];
            if (sl == 0) { if (fr == 0) {
#pragma unroll
                for (int r = 0; r < 4; ++r) out[O_N + sidx * 128 + 16 * wave + 4 * fq + r] = st[EB - 1][r]; }
                if (tid == 0) out[O_M + sidx] = m; }
        } else { const int sidx = (b * 2 + dir) * 16 + hd;
#pragma unroll
            for (int eb = 0; eb < 4; ++eb) *(f32x4*)(out + O_S + (size_t)sidx * 8192 + (16 * eb + fr) * 128 + 16 * wave + 4 * fq) = st[eb]; }
    }
#undef ISSUE_LOADS
#undef TROW
}

constexpr int CW_SQUEUE = 3584;
__device__ __forceinline__ void p4_phase(const Args& a, lds8* lds, int tid, int lane, int wave, int blk, int nblk) {
    const bool split = (nblk == 256);
    constexpr int NSCAN = 208, NCOPY = 48;
    if (split && blk >= NSCAN) { transpose_items(a, lds, lane, wave, (blk - NSCAN) * 8 + wave, NCOPY * 8, TI_1, TI_ALL); return; }
    volatile LAS unsigned* qslot = (volatile LAS unsigned*)(lds + LDS_BYTES - 32);
    unsigned* qcnt = (unsigned*)(a.ws + WS_CTL) + CW_SQUEUE;
    bool long_pending = split && blk < 128; int vb = blk, i = 0;
    for (;;) {
        bool lng, ml; int u;
        if (split) {
            if (long_pending) { long_pending = false; lng = true; ml = blk < 64; u = blk & 63; }
            else {
                __syncthreads();
                if (tid == 0) qslot[0] = xb_add(qcnt, 1u);
                __syncthreads();
                const int sid = (int)qslot[0];
                if (sid >= 1024) break;
                lng = false; ml = (sid & 1) != 0; u = sid >> 1; }
        } else {
            if (vb >= 256) break;
            lng = vb < 128; const int n = lng ? 1 : 8, sid = (vb - 128) * 8 + i; ml = lng ? (vb < 64) : ((sid & 1) != 0); u = lng ? (vb & 63) : (sid >> 1);
            if (++i >= n) { i = 0; vb += nblk; }
        }
        if (ml) scan_unit<true>(a, lds, lng, u, tid, lane, wave); else scan_unit<false>(a, lds, lng, u, tid, lane, wave);
    }
}

__device__ __forceinline__ void ld16bf(const bf16_t* p, float* f) { const u32x4 a = *(const u32x4*)p, b = *(const u32x4*)(p + 8);
#pragma unroll
    for (int q = 0; q < 4; ++q) { f[2 * q] = bflo(a[q]); f[2 * q + 1] = bfhi(a[q]); f[8 + 2 * q] = bflo(b[q]); f[8 + 2 * q + 1] = bfhi(b[q]); } }
__device__ __forceinline__ void st16f8(unsigned char* p, const float* f) { u32x4 w;
#pragma unroll
    for (int q = 0; q < 4; ++q) { int t = __builtin_amdgcn_cvt_pk_fp8_f32(f[4 * q], f[4 * q + 1], 0, false); t = __builtin_amdgcn_cvt_pk_fp8_f32(f[4 * q + 2], f[4 * q + 3], t, true); w[q] = (unsigned)t; }
    *(u32x4*)p = w; }
__device__ __forceinline__ void st16bf(bf16_t* p, const float* f) { u32x4 a, b;
#pragma unroll
    for (int q = 0; q < 4; ++q) { a[q] = pk2(f[2 * q], f[2 * q + 1]); b[q] = pk2(f[8 + 2 * q], f[8 + 2 * q + 1]); }
    *(u32x4*)p = a; *(u32x4*)(p + 8) = b; }
__device__ __forceinline__ void cv16(const u32x4& a, const u32x4& b, float* f) {
#pragma unroll
    for (int q = 0; q < 4; ++q) { f[2 * q] = bflo(a[q]); f[2 * q + 1] = bfhi(a[q]); f[8 + 2 * q] = bflo(b[q]); f[8 + 2 * q + 1] = bfhi(b[q]); } }
__device__ __forceinline__ void p5_phase(const Args& a, int lane, int wave, int blk, int nblk) {
    const bf16_t* P = (const bf16_t*)(a.ws + WS_P); const bf16_t* XC = (const bf16_t*)(a.ws + WS_XC); const bf16_t* HY = (const bf16_t*)(a.ws + WS_HY); bf16_t* A2 = (bf16_t*)(a.ws + WS_U);
    const int c0 = 16 * lane, NGW = nblk * 8;
    float gml[16], gss[16];
#pragma unroll
    for (int i = 0; i < 4; ++i) { const f32x4 g = *(const f32x4*)(a.in[I_GML] + c0 + 4 * i), h = *(const f32x4*)(a.in[I_GSSD] + c0 + 4 * i);
#pragma unroll
        for (int j = 0; j < 4; ++j) { gml[4 * i + j] = g[j]; gss[4 * i + j] = h[j]; } }
    const float dsk = a.in[I_DSKIP][c0 >> 6];
    for (int row0 = blk * 8 + wave; row0 < NTOK; row0 += 2 * NGW) {
        u32x4 L[2][14];
#pragma unroll
        for (int q = 0; q < 2; ++q) { const int row = row0 + q * NGW; if (row < NTOK) {
            const bf16_t* hp = HY + (size_t)row * 1024 + c0; const bf16_t* pp = P + (size_t)row * NPJ + c0; const bf16_t* xp = XC + (size_t)row * DM + c0;
#pragma unroll
            for (int d = 0; d < 4; ++d) { L[q][2 * d] = *(const u32x4*)(hp + d * HY_STRIDE); L[q][2 * d + 1] = *(const u32x4*)(hp + d * HY_STRIDE + 8); }
            L[q][8] = *(const u32x4*)(pp + 2048); L[q][9] = *(const u32x4*)(pp + 2048 + 8); L[q][10] = *(const u32x4*)(pp + 3072); L[q][11] = *(const u32x4*)(pp + 3072 + 8);
            L[q][12] = *(const u32x4*)xp; L[q][13] = *(const u32x4*)(xp + 8); } }
        SBAR0();
#pragma unroll
        for (int q = 0; q < 2; ++q) { const int row = row0 + q * NGW; if (row < NTOK) {
            float h[16], t[16], o[16];
            cv16(L[q][0], L[q][1], h); cv16(L[q][2], L[q][3], t); cv16(L[q][8], L[q][9], o);
            float ss = 0.f;
#pragma unroll
            for (int i = 0; i < 16; ++i) { h[i] += t[i]; ss += h[i] * h[i]; }
            ss += __shfl_xor(ss, 1); ss += __shfl_xor(ss, 2); ss += __shfl_xor(ss, 4); ss += __shfl_xor(ss, 8);
            float rstd = rsqrtf(ss * (1.f / 256.f) + EPS);
#pragma unroll
            for (int i = 0; i < 16; ++i) h[i] = h[i] * rstd * gml[i] * sigmf(o[i]);
            st16f8((unsigned char*)A2 + (size_t)row * DM + c0, h);
            cv16(L[q][4], L[q][5], h); cv16(L[q][6], L[q][7], t); cv16(L[q][12], L[q][13], o);
#pragma unroll
            for (int i = 0; i < 16; ++i) h[i] = h[i] + t[i] + dsk * o[i];
            cv16(L[q][10], L[q][11], o);
            ss = 0.f;
#pragma unroll
            for (int i = 0; i < 16; ++i) { h[i] *= siluf(o[i]); ss += h[i] * h[i]; }
            rstd = rsqrtf(wave_sum(ss) * (1.f / 1024.f) + EPS);
#pragma unroll
            for (int i = 0; i < 16; ++i) h[i] = h[i] * rstd * gss[i];
            st16f8((unsigned char*)A2 + (size_t)row * DM + 1024 + c0, h); } }
    }
}

__device__ __forceinline__ void p7_phase(const Args& a, int lane, int wave, int blk, int nblk) {
    const bf16_t* MIX = (const bf16_t*)(a.ws + WS_MIX); const float* MOD = (const float*)(a.ws + WS_MOD); const float* MODC = (const float*)(a.ws + WS_MODC);
    bf16_t* U = (bf16_t*)(a.ws + WS_U); bf16_t* X1 = (bf16_t*)(a.ws + WS_X1);
    for (int row = blk * 8 + wave; row < NTOK; row += nblk * 8) {
        const u32x2* mr = (const u32x2*)(MIX + (size_t)row * DM) + lane; const f32x4* xr = (const f32x4*)xrow_ptr(a, row) + lane;
        const int cnd = cond_of(row); const float* mc = MODC + cnd * 3 * DM; const float* sh2 = MOD + cnd * 12288 + 6144;
        u32x2 mw[8]; f32x4 xv[8], dv[8], bv[8], cv[8];
#pragma unroll
        for (int j = 0; j < 8; ++j) { const int col = 4 * lane + 256 * j; mw[j] = mr[64 * j]; xv[j] = xr[64 * j]; dv[j] = *(const f32x4*)(mc + col); bv[j] = *(const f32x4*)(mc + DM + col); cv[j] = *(const f32x4*)(sh2 + col); }
        SBAR0();
        f32x4 v[8]; float ss = 0.f;
#pragma unroll
        for (int j = 0; j < 8; ++j) { const u32x2 w = mw[j]; v[j] = (f32x4){bflo(w.x), bfhi(w.x), bflo(w.y), bfhi(w.y)}; ss += (v[j][0] * v[j][0] + v[j][1] * v[j][1]) + (v[j][2] * v[j][2] + v[j][3] * v[j][3]); }
        float rstd = rsqrtf(wave_sum(ss) * (1.f / DM) + EPS); ss = 0.f;
#pragma unroll
        for (int j = 0; j < 8; ++j) { const int col = 4 * lane + 256 * j;
            v[j] = xv[j] + dv[j] * (v[j] * rstd);
            { u32x2 w; w.x = pk2(v[j][0], v[j][1]); w.y = pk2(v[j][2], v[j][3]); *(u32x2*)(X1 + (size_t)row * DM + col) = w; }
            ss += (v[j][0] * v[j][0] + v[j][1] * v[j][1]) + (v[j][2] * v[j][2] + v[j][3] * v[j][3]); }
        rstd = rsqrtf(wave_sum(ss) * (1.f / DM) + EPS);
#pragma unroll
        for (int j = 0; j < 8; ++j) { const int col = 4 * lane + 256 * j;
            const f32x4 o = v[j] * rstd * bv[j] + cv[j];
            int p = __builtin_amdgcn_cvt_pk_fp8_f32(o[0], o[1], 0, false); p = __builtin_amdgcn_cvt_pk_fp8_f32(o[2], o[3], p, true);
            *(int*)((unsigned char*)U + (size_t)row * DM + col) = p; }
    }
}
__device__ __forceinline__ void p10_phase(const Args& a, int lane, int wave, int blk, int nblk) {
    const bf16_t* MO = (const bf16_t*)(a.ws + WS_MIX); const bf16_t* X1 = (const bf16_t*)(a.ws + WS_X1); const float* MODC = (const float*)(a.ws + WS_MODC);
    const int NGW = nblk * 8;
    for (int row0 = blk * 8 + wave; row0 < NTOK; row0 += 2 * NGW) {
        u32x2 mw[2][8], xw[2][8]; f32x4 ev[2][8];
#pragma unroll
        for (int q = 0; q < 2; ++q) { const int row = row0 + q * NGW; if (row < NTOK) {
            const u32x2* mr = (const u32x2*)(MO + (size_t)row * DM) + lane; const u32x2* x1r = (const u32x2*)(X1 + (size_t)row * DM) + lane; const float* mc = MODC + cond_of(row) * 3 * DM + 2 * DM;
#pragma unroll
            for (int j = 0; j < 8; ++j) { mw[q][j] = mr[64 * j]; xw[q][j] = x1r[64 * j]; ev[q][j] = *(const f32x4*)(mc + 4 * lane + 256 * j); } } }
        SBAR0();
#pragma unroll
        for (int q = 0; q < 2; ++q) { const int row = row0 + q * NGW; if (row < NTOK) {
            f32x4* yr = (f32x4*)(a.out + O_Y + (size_t)row * DM) + lane;
            f32x4 v[8]; float ss = 0.f;
#pragma unroll
            for (int j = 0; j < 8; ++j) { const u32x2 w = mw[q][j]; v[j] = (f32x4){bflo(w.x), bfhi(w.x), bflo(w.y), bfhi(w.y)}; ss += (v[j][0] * v[j][0] + v[j][1] * v[j][1]) + (v[j][2] * v[j][2] + v[j][3] * v[j][3]); }
            const float rstd = rsqrtf(wave_sum(ss) * (1.f / DM) + EPS);
#pragma unroll
            for (int j = 0; j < 8; ++j) { const u32x2 w = xw[q][j]; const f32x4 x1 = (f32x4){bflo(w.x), bfhi(w.x), bflo(w.y), bfhi(w.y)};
                yr[64 * j] = x1 + ev[q][j] * (v[j] * rstd); } } }
    }
}

#ifndef PH_MASK
#define PH_MASK 0x7ff
#endif
#define RUN(k) if constexpr (((PH_MASK) >> (k)) & 1)
#define GRID_SYNC() xcd_barrier(bar)
__global__ void __launch_bounds__(NTHR, 2) fwd_kernel(Args a) {
    extern __shared__ __attribute__((aligned(16))) unsigned char lds_raw[];
    lds8* lds = (lds8*)lds_raw;
    cg::grid_group grid = cg::this_grid();
    const int blk = blockIdx.x, nblk = gridDim.x;
#define FRESH() int tid = threadIdx.x; asm volatile("" : "+v"(tid)); const int lane = tid & 63, wave = __builtin_amdgcn_readfirstlane(tid >> 6); (void)lane; (void)wave

    volatile LAS unsigned* bst = (volatile LAS unsigned*)(lds + LDS_BYTES - 64);
    if (threadIdx.x < 2) bst[threadIdx.x] = 0u;
    unsigned* barw = (unsigned*)(a.ws + WS_CTL);
    if (a.ws == nullptr) grid.sync();
    __syncthreads();
    const XcdBarrier bar = xcd_barrier_post(barw, bst);
    RUN(0) { FRESH(); p0_phase(a, lds, tid, lane, wave, blk, nblk); }
    GRID_SYNC();
    RUN(1) { FRESH(); p1_phase(a, lds, tid, lane, wave, blk, nblk); }
    GRID_SYNC();
    RUN(2) {
        { pg8::Gemm g{(const pg8::bf16_t*)(a.ws + WS_U), (const pg8::bf16_t*)(a.ws + WS_WIN), NTOK, NPJ, DM}; pg8::SkipOrder S; S.base.init(NTOK, 16 * 256, nblk, blk); S.skip_from = 8; S.skip_by = 8;
          pg8::EpiBf16<0> E{(pg8::bf16_t*)(a.ws + WS_P), NPJ};
          pg8::gemm_phase<pg8::EpiBf16<0>, pg8::SkipOrder, true, true>(lds, g, S, E); }
        { pg8::Gemm g{(const pg8::bf16_t*)(a.ws + WS_U8), (const pg8::bf16_t*)(a.ws + WS_WIN8), NTOK, 2048, DM / 2}; pg8::StaticOrder S; S.init(NTOK, 2048, nblk, blk);
          pg8::EpiBf16<0> E{(pg8::bf16_t*)(a.ws + WS_P) + 2048, NPJ};
          pg8::gemm_phase<pg8::EpiBf16<0>, pg8::StaticOrder, true, true, true>(lds, g, S, E); }
    }
    GRID_SYNC();
    RUN(3) { FRESH(); p3_phase(a, tid, blk, nblk); }
    GRID_SYNC();
    RUN(4) { FRESH(); p4_phase(a, lds, tid, lane, wave, blk, nblk); }
    GRID_SYNC();
    RUN(5) { FRESH(); p5_phase(a, lane, wave, blk, nblk); }
    GRID_SYNC();
    RUN(6) {
        pg8::Gemm g{(const pg8::bf16_t*)(a.ws + WS_U), (const pg8::bf16_t*)(a.ws + WS_WOUT), NTOK, DM, DM / 2}; pg8::StaticOrder S; S.init(NTOK, DM, nblk, blk);
        pg8::EpiBf16<0> E{(pg8::bf16_t*)(a.ws + WS_MIX), DM};
        pg8::gemm_phase<pg8::EpiBf16<0>, pg8::StaticOrder, true, true, true>(lds, g, S, E);
    }
    GRID_SYNC();
    RUN(7) { FRESH(); p7_phase(a, lane, wave, blk, nblk); }
    GRID_SYNC();
    RUN(8) {
        pg8::Gemm g{(const pg8::bf16_t*)(a.ws + WS_U), (const pg8::bf16_t*)(a.ws + WS_WMI), NTOK, DFF, DM / 2}; pg8::StaticOrder S; S.init(NTOK, DFF, nblk, blk);
        pg8::EpiFp8Relu2 E{a.ws + WS_HDN, DFF};
        pg8::gemm_phase<pg8::EpiFp8Relu2, pg8::StaticOrder, true, true, true>(lds, g, S, E);
    }
    GRID_SYNC();
    RUN(9) {
        pg8::Gemm g{(const pg8::bf16_t*)(a.ws + WS_HDN), (const pg8::bf16_t*)(a.ws + WS_WMO), NTOK, DM, DFF / 2}; pg8::StaticOrder S; S.init(NTOK, DM, nblk, blk);
        pg8::EpiBf16<0> E{(pg8::bf16_t*)(a.ws + WS_MIX), DM};
        pg8::gemm_phase<pg8::EpiBf16<0>, pg8::StaticOrder, true, true, true>(lds, g, S, E);
    }
    GRID_SYNC();
    RUN(10) { FRESH(); p10_phase(a, lane, wave, blk, nblk); }
}

extern "C" void kernel_launch(void* const* d_in, const int* in_sizes, int n_in, void* d_out, int out_size, void* d_ws, size_t ws_size, hipStream_t stream) {
    static int grid = 0;
    if (grid == 0) {
        if (n_in != 27 || ws_size < WS_END) { fprintf(stderr, "kernel_launch: expected 27 inputs and >= %zu bytes of workspace (got %d, %zu)\n", (size_t)WS_END, n_in, ws_size); grid = -1; return; }
        int dev = 0, cus = 0, per_cu = 0;
        hipGetDevice(&dev); hipDeviceGetAttribute(&cus, hipDeviceAttributeMultiprocessorCount, dev);
        if (hipFuncSetAttribute((const void*)fwd_kernel, hipFuncAttributeMaxDynamicSharedMemorySize, LDS_BYTES) != hipSuccess) { fprintf(stderr, "kernel_launch: hipFuncSetAttribute failed\n"); grid = -1; return; }
        if (hipOccupancyMaxActiveBlocksPerMultiprocessor(&per_cu, (const void*)fwd_kernel, NTHR, LDS_BYTES) != hipSuccess || per_cu < 1) { fprintf(stderr, "kernel_launch: occupancy query failed (%d)\n", per_cu); (void)hipGetLastError(); per_cu = 1; }
        grid = cus * (per_cu > 1 ? 1 : per_cu);
        if (grid > 256) grid = 256;
    }
    if (grid < 0) return;
    Args a{};
    for (int i = 0; i < 27; ++i) a.in[i] = (const float*)d_in[i];
    a.out = (float*)d_out; a.ws = (unsigned char*)d_ws;
    if (hipMemsetAsync((char*)d_ws + WS_CTL, 0, 16384, stream) != hipSuccess) { fprintf(stderr, "kernel_launch: memset of the barrier words failed\n"); return; }
    void* args[] = {&a};
    hipError_t e = hipLaunchCooperativeKernel((const void*)fwd_kernel, dim3(grid), dim3(NTHR), args, LDS_BYTES, stream);
    if (e != hipSuccess) fprintf(stderr, "kernel_launch: cooperative launch failed: %s (grid %d)\n", hipGetErrorString(e), grid);
}
```
